# Optimizing an MI355X kernel written in HIP

```python
import jax, jax.numpy as jnp
from jax import lax
import numpy as np

D_MODEL = 1024
BATCH = 4
SEQ = 8192
DEPTH = 1

D_CONV = D_MODEL
CONV_WIDTH = 3
CONV_GROUPS = 8
D_POOL = D_MODEL
POOL_WINDOWS = (2, 4, 8, 16)
N_POOL_GROUPS = len(POOL_WINDOWS)
POOL_GROUP = D_POOL // N_POOL_GROUPS
IN_COLS = 3 * D_CONV + D_POOL + 2 * D_MODEL
IN_SPLITS = (D_CONV, 2 * D_CONV, 3 * D_CONV, 3 * D_CONV + D_POOL, 3 * D_CONV + D_POOL + D_MODEL)
N_GROUPS = 8
EXPERTS_PER_GROUP = 8
N_EXPERTS = N_GROUPS * EXPERTS_PER_GROUP
TOP_K = 2
D_EXPERT = 512
MOE_BLOCK = 128
LN_EPS = 1e-5
DEEPNORM_ALPHA = (2.0 * DEPTH) ** 0.25
DEEPNORM_BETA = (8.0 * DEPTH) ** -0.25
N_MOD = 6

kernel_name = "hybrid_conv_pool_hmoe_deepnorm_adaln"


def layer_norm(x, g, b):
    xf = x.astype(jnp.float32)
    mu = jnp.mean(xf, axis=-1, keepdims=True)
    var = jnp.mean(jnp.square(xf - mu), axis=-1, keepdims=True)
    y = (xf - mu) * lax.rsqrt(var + LN_EPS) * g.astype(jnp.float32) + b.astype(jnp.float32)
    return y.astype(x.dtype)


def causal_depthwise_conv(z, w):
    return lax.conv_general_dilated(
        z, w[:, None, :].astype(z.dtype), window_strides=(1,),
        padding=((CONV_WIDTH - 1, 0),), dimension_numbers=('NWC', 'WIO', 'NWC'),
        feature_group_count=z.shape[-1])


def causal_multiscale_pool(z):
    S = z.shape[1]
    zf = z.astype(jnp.float32)
    cs = jnp.pad(jnp.cumsum(zf, axis=1), ((0, 0), (1, 0), (0, 0)))
    t = jnp.arange(S)
    outs = []
    for gi, w in enumerate(POOL_WINDOWS):
        c = cs[:, :, gi * POOL_GROUP:(gi + 1) * POOL_GROUP]
        lower = jnp.pad(c[:, :S + 1 - w], ((0, 0), (w - 1, 0), (0, 0)))
        count = jnp.minimum(t + 1, w).astype(jnp.float32)[None, :, None]
        outs.append((c[:, 1:] - lower) / count - zf[:, :, gi * POOL_GROUP:(gi + 1) * POOL_GROUP])
    return jnp.stack(outs, axis=2).astype(z.dtype)


def hybrid_mixer(u, w_in, conv_w, w_out_conv, w_pool, pool_scale, w_o):
    proj = jnp.einsum('bsd,de->bse', u, w_in)
    a_val, a_b, a_c, p_in, g_a, g_b = jnp.split(proj, IN_SPLITS, axis=-1)
    y_a = causal_depthwise_conv(a_c * a_val, conv_w) * a_b
    y_a = jnp.einsum('bsc,cd->bsd', y_a, w_out_conv)
    pooled = causal_multiscale_pool(p_in)
    y_b = jnp.einsum('bsgc,gce->bsge', pooled, w_pool)
    y_b = y_b.reshape(u.shape[0], u.shape[1], D_POOL) * pool_scale
    merged = jax.nn.sigmoid(g_a) * y_a + jax.nn.sigmoid(g_b) * y_b
    return jnp.einsum('bsd,de->bse', merged, w_o)


def hierarchical_route(h, w_group, b_group, w_router, b_router):
    n = h.shape[0]
    hf = h.astype(jnp.float32)
    g_prob = jax.nn.softmax(hf @ w_group.astype(jnp.float32) + b_group.astype(jnp.float32), axis=-1)
    g_top_p, g_top = lax.top_k(g_prob, 1)
    e_logits = (hf @ w_router.astype(jnp.float32)).reshape(n, N_GROUPS, EXPERTS_PER_GROUP)
    e_logits = e_logits + b_router.astype(jnp.float32)
    e_logits = jnp.take_along_axis(e_logits, g_top[:, :, None], axis=1)[:, 0]
    e_prob = jax.nn.softmax(e_logits, axis=-1)
    e_top_p, e_top = lax.top_k(e_prob, TOP_K)
    e_top_p = e_top_p / jnp.sum(e_top_p, axis=-1, keepdims=True)
    return g_top * EXPERTS_PER_GROUP + e_top, g_top_p * e_top_p


def routed_experts(h, expert_idx, expert_w, w_gate, w_up, w_down):
    n = h.shape[0]
    n_assign = n * TOP_K
    n_blocks = -(-n_assign // MOE_BLOCK) + N_EXPERTS
    cap = n_blocks * MOE_BLOCK
    flat_e = expert_idx.reshape(-1).astype(jnp.int32)
    order = jnp.argsort(flat_e)
    sorted_e = flat_e[order]
    token_of = (order // TOP_K).astype(jnp.int32)
    counts = jnp.bincount(flat_e, length=N_EXPERTS)
    padded = (counts + MOE_BLOCK - 1) // MOE_BLOCK * MOE_BLOCK
    pad_end = jnp.cumsum(padded)
    pad_start = pad_end - padded
    seg_start = jnp.cumsum(counts) - counts
    dest = pad_start[sorted_e] + jnp.arange(n_assign, dtype=jnp.int32) - seg_start[sorted_e]
    buf_tok = jnp.zeros((cap,), jnp.int32).at[dest].set(token_of)
    buf_w = jnp.zeros((cap,), h.dtype).at[dest].set(expert_w.reshape(-1)[order].astype(h.dtype))
    block_expert = jnp.minimum(
        jnp.searchsorted(pad_end, jnp.arange(n_blocks) * MOE_BLOCK, side='right'), N_EXPERTS - 1)

    def expert_block(args):
        tok, e = args
        xb = h[tok]
        act = jax.nn.silu(xb @ w_gate[e]) * (xb @ w_up[e])
        return act @ w_down[e]

    rows = lax.map(expert_block, (buf_tok.reshape(n_blocks, MOE_BLOCK), block_expert))
    rows = rows.reshape(cap, h.shape[1]) * buf_w[:, None]
    return jax.ops.segment_sum(rows, buf_tok, num_segments=n)


def setup_inputs(seed: int = 0) -> dict:
    key = jax.random.key(seed)
    ks = jax.random.split(key, 24)
    L = DEPTH
    beta = DEEPNORM_BETA

    def nrm(k, shape, s):
        return jax.random.normal(k, shape, jnp.float32) * s

    col_scale = jnp.concatenate([
        jnp.full((D_CONV,), beta, jnp.float32), jnp.ones((2 * D_CONV,), jnp.float32),
        jnp.full((D_POOL,), beta, jnp.float32), jnp.ones((2 * D_MODEL,), jnp.float32)])
    return {
        "x": nrm(ks[0], (BATCH, SEQ, D_MODEL), 1.0),
        "c": nrm(ks[1], (BATCH, D_MODEL), 1.0),
        "w_ada": nrm(ks[2], (L, D_MODEL, N_MOD * D_MODEL), 0.1 * D_MODEL ** -0.5),
        "b_ada": nrm(ks[3], (L, N_MOD * D_MODEL), 0.01),
        "w_in": nrm(ks[4], (L, D_MODEL, IN_COLS), D_MODEL ** -0.5) * col_scale,
        "conv_w": nrm(ks[5], (L, CONV_WIDTH, D_CONV), CONV_WIDTH ** -0.5),
        "w_out_conv": nrm(ks[6], (L, D_CONV, D_MODEL), beta * D_CONV ** -0.5),
        "w_pool": nrm(ks[7], (L, N_POOL_GROUPS, POOL_GROUP, POOL_GROUP), beta * POOL_GROUP ** -0.5),
        "pool_scale": 1.0 + nrm(ks[8], (L, D_POOL), 0.1),
        "w_o": nrm(ks[9], (L, D_MODEL, D_MODEL), beta * D_MODEL ** -0.5),
        "ln1_g": 1.0 + nrm(ks[10], (L, D_MODEL), 0.05),
        "ln1_b": nrm(ks[11], (L, D_MODEL), 0.02),
        "w_group": nrm(ks[12], (L, D_MODEL, N_GROUPS), D_MODEL ** -0.5),
        "b_group": nrm(ks[13], (L, N_GROUPS), 0.01),
        "w_router": nrm(ks[14], (L, D_MODEL, N_EXPERTS), D_MODEL ** -0.5),
        "b_router": nrm(ks[15], (L, N_GROUPS, EXPERTS_PER_GROUP), 0.01),
        "w_gate": nrm(ks[16], (L, N_EXPERTS, D_MODEL, D_EXPERT), D_MODEL ** -0.5),
        "w_up": nrm(ks[17], (L, N_EXPERTS, D_MODEL, D_EXPERT), beta * D_MODEL ** -0.5),
        "w_down": nrm(ks[18], (L, N_EXPERTS, D_EXPERT, D_MODEL), beta * D_EXPERT ** -0.5),
        "ln2_g": 1.0 + nrm(ks[19], (L, D_MODEL), 0.05),
        "ln2_b": nrm(ks[20], (L, D_MODEL), 0.02),
    }


def reference(x, c, w_ada, b_ada, w_in, conv_w, w_out_conv, w_pool, pool_scale, w_o,
              ln1_g, ln1_b, w_group, b_group, w_router, b_router, w_gate, w_up, w_down,
              ln2_g, ln2_b):
    bsz, seq, d = x.shape
    for l in range(DEPTH):
        mod = (jax.nn.silu(c) @ w_ada[l] + b_ada[l]).reshape(bsz, N_MOD, d)[:, :, None, :]
        shift1, scale1, gate1, shift2, scale2, gate2 = [mod[:, i] for i in range(N_MOD)]
        u = x * (1.0 + scale1) + shift1
        mix = hybrid_mixer(u, w_in[l], conv_w[l], w_out_conv[l], w_pool[l], pool_scale[l], w_o[l])
        x = layer_norm(DEEPNORM_ALPHA * x + (1.0 + gate1) * mix, ln1_g[l], ln1_b[l])
        h = (x * (1.0 + scale2) + shift2).reshape(bsz * seq, d)
        idx, wts = hierarchical_route(h, w_group[l], b_group[l], w_router[l], b_router[l])
        y = routed_experts(h, idx, wts, w_gate[l], w_up[l], w_down[l]).reshape(bsz, seq, d)
        x = layer_norm(DEEPNORM_ALPHA * x + (1.0 + gate2) * y, ln2_g[l], ln2_b[l])
    return x
```

```cpp
#define MK_N_LAUNCHES 1
#include <hip/hip_runtime.h>
#include <cstdio>
#include <cstdint>
namespace pg8 {
#define PG8_LAS __attribute__((address_space(3)))
typedef unsigned short bf16_t;
typedef short bf16x8 __attribute__((ext_vector_type(8)));
typedef float f32x4 __attribute__((ext_vector_type(4)));
typedef unsigned u32x4 __attribute__((ext_vector_type(4)));
constexpr int BM = 256, BK = 64, HALF = 128, HTB = HALF * BK * 2  , STAGE_BYTES = 8 * HTB, NXCD = 8, WGM = 8;

__host__ __device__ __forceinline__ int lds_byte(int r, int c) { const int st = (r >> 4) * 2 + (c >> 5), rr = r & 15, cc = c & 31, ob = rr * 64 + cc * 2; return st * 1024 + (ob ^ (((ob >> 9) & 1) << 5)); }
__host__ __device__ __forceinline__ void stage_rc(int b, int& R, int& C) { const int st = b / 1024, sb = b % 1024, swz = sb ^ (((sb >> 9) & 1) << 5); R = (st >> 1) * 16 + swz / 64; C = (st & 1) * 32 + (swz % 64) / 2; }
__host__ __device__ __forceinline__ int perm32(int rho) { const int n = rho >> 4, i = rho & 15; return 8 * (i >> 2) + 4 * n + (i & 3); }

struct Unit { int pm, pn, ord, hm; };
struct Gemm { const bf16_t* A; const bf16_t* Bt; int M, N, K; };

struct StaticOrder {
    int nM, nN, nwg, G, c;
    __host__ __device__ void init(int M, int N, int G_, int c_) { nM = M / BM; nN = N / BM; nwg = nM * nN; G = G_; c = c_; }
    __host__ __device__ bool next(int i, Unit& u) const {
        const long L = (long)i * G + c; if (L >= nwg) return false;
        int wgid = (int)L; { const int q = nwg / NXCD, r = nwg % NXCD, xcd = wgid % NXCD, off = wgid / NXCD; wgid = (xcd < r ? xcd * (q + 1) : r * (q + 1) + (xcd - r) * q) + off; }
        const int nig = WGM * nN, gid = wgid / nig, fm = gid * WGM, gsz = (nM - fm) < WGM ? (nM - fm) : WGM;
        u.pm = fm + ((wgid % nig) % gsz); u.pn = (wgid % nig) / gsz; u.ord = i; u.hm = 0; return true;
    }
    __device__ __forceinline__ void a_ready(const Unit&) const {}
    __device__ __forceinline__ void done(const Unit&) const {}
};
typedef __bf16 bf16v2_t __attribute__((ext_vector_type(2)));
typedef float f32x2 __attribute__((ext_vector_type(2)));
__device__ __forceinline__ unsigned cvt_pk_bf16(float lo, float hi) { const bf16v2_t r = __builtin_convertvector((f32x2){lo, hi}, bf16v2_t); return __builtin_bit_cast(unsigned, r); }

typedef unsigned u32x2 __attribute__((ext_vector_type(2)));
__device__ __forceinline__ float bf_lo(unsigned w) { return __builtin_bit_cast(float, w << 16); }
__device__ __forceinline__ float bf_hi(unsigned w) { return __builtin_bit_cast(float, w & 0xffff0000u); }
__device__ __forceinline__ float sigmoidf_(float x) { return __builtin_amdgcn_rcpf(1.0f + __expf(-x)); }
__device__ __forceinline__ u32x4 pack8(const f32x4 v0, const f32x4 v1) { u32x4 w; w.x = cvt_pk_bf16(v0[0], v0[1]); w.y = cvt_pk_bf16(v0[2], v0[3]); w.z = cvt_pk_bf16(v1[0], v1[1]); w.w = cvt_pk_bf16(v1[2], v1[3]); return w; }

__device__ __forceinline__ unsigned pk4_u8(float a, float b, float c, float d) { int r = 0; r = __builtin_amdgcn_cvt_pk_u8_f32(a * 255.0f, 0, r); r = __builtin_amdgcn_cvt_pk_u8_f32(b * 255.0f, 1, r); r = __builtin_amdgcn_cvt_pk_u8_f32(c * 255.0f, 2, r); r = __builtin_amdgcn_cvt_pk_u8_f32(d * 255.0f, 3, r); return (unsigned)r; }
__device__ __forceinline__ float u8f(unsigned w, int b) { return (float)((w >> (8 * b)) & 0xffu) * (1.0f / 255.0f); }
template <int CTRL> __device__ __forceinline__ float dpp_mov(float v) { return __builtin_bit_cast(float, __builtin_amdgcn_update_dpp(0, __builtin_bit_cast(int, v), CTRL, 0xF, 0xF, false)); }
template <int CTRL> __device__ __forceinline__ unsigned dpp_fillu(unsigned old, unsigned v) { return (unsigned)__builtin_amdgcn_update_dpp((int)old, (int)v, CTRL, 0xF, 0xF, false); }
template <int CTRL> __device__ __forceinline__ float dpp_fill(float old, float v) { return __builtin_bit_cast(float, __builtin_amdgcn_update_dpp(__builtin_bit_cast(int, old), __builtin_bit_cast(int, v), CTRL, 0xF, 0xF, false)); }
__device__ __forceinline__ size_t blk_index(int pm, int g, int wave, int ai, int bj, int m) { return (size_t)((((((pm * 4 + g) * 8 + wave) * 2 + ai) * 2 + bj) * 4 + m)); }
struct EpiProj {
    static constexpr bool PERM = true, AFTER_DRAIN = false;
    bf16_t *A2; unsigned char* GA; bf16_t* Q; unsigned char* GB; bf16_t *VH, *ABH, *VT; const PG8_LAS float* conv_w; PG8_LAS float* xb;
    __device__ __forceinline__ void operator()(const f32x4 (&acc)[2][2][4][2], const Unit& u, int wr, int wc, int fr, int fq) const {
        const int row0 = u.pm * BM + wr * 64 + fr, pn = u.pn;
        if (pn >= 16) {
            const int g = pn & 3, wave = wr * 4 + wc, lane8 = (fq * 16 + fr) * 8;
            if (pn < 20) {
#pragma unroll
                for (int ai = 0; ai < 2; ++ai)
#pragma unroll
                    for (int m = 0; m < 4; ++m)
#pragma unroll
                        for (int bj = 0; bj < 2; ++bj) *(u32x4*)(Q + blk_index(u.pm, g, wave, ai, bj, m) * 512 + lane8) = pack8(acc[ai][bj][m][0], acc[ai][bj][m][1]);
            } else {
#pragma unroll
                for (int ai = 0; ai < 2; ++ai)
#pragma unroll
                    for (int m = 0; m < 4; ++m)
#pragma unroll
                        for (int bj = 0; bj < 2; ++bj) { f32x4 v0 = acc[ai][bj][m][0], v1 = acc[ai][bj][m][1];
#pragma unroll
                            for (int j = 0; j < 4; ++j) { v0[j] = sigmoidf_(v0[j]); v1[j] = sigmoidf_(v1[j]); }
                            *(u32x2*)(GB + blk_index(u.pm, g, wave, ai, bj, m) * 512 + lane8) = (u32x2){pk4_u8(v0[0], v0[1], v0[2], v0[3]), pk4_u8(v1[0], v1[1], v1[2], v1[3])}; }
            }
            return;
        }
        const int ch0 = pn * 64 + wc * 16 + 4 * fq;
        const f32x4 w0 = *(const PG8_LAS f32x4*)(conv_w + ch0), w1 = *(const PG8_LAS f32x4*)(conv_w + 1024 + ch0), w2 = *(const PG8_LAS f32x4*)(conv_w + 2048 + ch0);
#pragma unroll
        for (int ai = 0; ai < 2; ++ai) { const f32x4 vt = acc[ai][0][3][0] * acc[ai][0][3][1];
            if (fr >= 14) { *(PG8_LAS f32x4*)(xb + ((wc * 4 + 2 * ai + wr) * 2 + (fr - 14)) * 16 + 4 * fq) = vt;
                if (ai == 1 && wr == 1) *(u32x2*)(VT + (size_t)(u.pm * 2 + (fr - 14)) * 1024 + ch0) = (u32x2){cvt_pk_bf16(vt[0], vt[1]), cvt_pk_bf16(vt[2], vt[3])}; } }
        asm volatile("s_waitcnt lgkmcnt(0)" ::: "memory"); __builtin_amdgcn_s_barrier(); asm volatile("" ::: "memory");
#pragma unroll
        for (int ai = 0; ai < 2; ++ai) { const int q = 2 * ai + wr;
            f32x4 t14 = (f32x4){0.f, 0.f, 0.f, 0.f}, t15 = t14, vprev = t14;
            if (q > 0) { t14 = *(const PG8_LAS f32x4*)(xb + ((wc * 4 + q - 1) * 2 + 0) * 16 + 4 * fq); t15 = *(const PG8_LAS f32x4*)(xb + ((wc * 4 + q - 1) * 2 + 1) * 16 + 4 * fq); }
            u32x2 a2w[4]; unsigned gaw[4];
#pragma unroll
            for (int m = 0; m < 4; ++m) { const f32x4 V = acc[ai][0][m][0] * acc[ai][0][m][1], ab = acc[ai][1][m][0]; f32x4 o, ga;
#pragma unroll
                for (int e = 0; e < 4; ++e) { float p1, p2;
                    if (m == 0) { p1 = t15[e]; p2 = fr == 1 ? t15[e] : t14[e]; } else { p1 = dpp_mov<0x10F>(vprev[e]); p2 = dpp_mov<0x10E>(vprev[e]); }
                    const float vm1 = dpp_fill<0x111>(p1, V[e]), vm2 = dpp_fill<0x112>(p2, V[e]);
                    o[e] = (w0[e] * vm2 + w1[e] * vm1 + w2[e] * V[e]) * ab[e]; ga[e] = sigmoidf_(acc[ai][1][m][1][e]); }
                if (q == 0 && m == 0 && fr < 2) { *(u32x2*)(VH + (size_t)(u.pm * 2 + fr) * 1024 + ch0) = (u32x2){cvt_pk_bf16(V[0], V[1]), cvt_pk_bf16(V[2], V[3])};
                    *(u32x2*)(ABH + (size_t)(u.pm * 2 + fr) * 1024 + ch0) = (u32x2){cvt_pk_bf16(ab[0], ab[1]), cvt_pk_bf16(ab[2], ab[3])}; }
                a2w[m] = (u32x2){cvt_pk_bf16(o[0], o[1]), cvt_pk_bf16(o[2], o[3])}; gaw[m] = pk4_u8(ga[0], ga[1], ga[2], ga[3]);
                vprev = V; }
            const bool odd = (fq & 1) != 0; const int chs = pn * 64 + wc * 16 + 4 * (fq & ~1);
#pragma unroll
            for (int mp = 0; mp < 2; ++mp) { const int m0 = 2 * mp, m1 = m0 + 1;
                const u32x2 sa = odd ? a2w[m0] : a2w[m1]; const unsigned sg = odd ? gaw[m0] : gaw[m1];
                u32x2 ra; ra.x = __shfl_xor(sa.x, 16); ra.y = __shfl_xor(sa.y, 16); const unsigned rg = __shfl_xor(sg, 16);
                const int mm = odd ? m1 : m0; const size_t off = (size_t)(row0 + ai * HALF + mm * 16) * 1024 + chs;
                const u32x4 wa = odd ? (u32x4){ra.x, ra.y, a2w[m1].x, a2w[m1].y} : (u32x4){a2w[m0].x, a2w[m0].y, ra.x, ra.y};
                const u32x2 wg = odd ? (u32x2){rg, gaw[m1]} : (u32x2){gaw[m0], rg};
                if (!(q == 0 && mm == 0 && fr < 2)) *(u32x4*)(A2 + off) = wa;
                *(u32x2*)(GA + blk_index(u.pm, pn >> 2, wr * 4 + 2 * (pn & 1) + (wc >> 1), ai, (pn & 3) >> 1, mm) * 512 + ((2 * (wc & 1) + (fq >> 1)) * 16 + fr) * 8) = wg; } }
    }
};
__device__ __forceinline__ float scan_pre(float x) { x += dpp_mov<0x111>(x); x += dpp_mov<0x112>(x); x += dpp_mov<0x114>(x); x += dpp_mov<0x118>(x); return x; }
__device__ __forceinline__ float scan_suf(float x) { x += dpp_mov<0x101>(x); x += dpp_mov<0x102>(x); x += dpp_mov<0x104>(x); x += dpp_mov<0x108>(x); return x; }
template <int W> __device__ __forceinline__ float pool_sum(float pre, float sufprev) { float t1 = 0.f; if constexpr (W < 16) t1 = dpp_mov<0x110 + W>(pre); return pre - t1 + dpp_mov<0x100 + (17 - W)>(sufprev); }
struct EpiMerge {
    static constexpr bool PERM = true, AFTER_DRAIN = false;
    const unsigned char* GA; const unsigned char* GB; const bf16_t* Q; bf16_t* MG;
    template <int W> __device__ __forceinline__ void tile(const f32x4 (&acc)[2][2][4][2], const Unit& u, int wr, int wc, int fr, int fq) const {
        const int rb = u.pm * BM + wr * 64; int col0 = u.pn * BM + wc * 32 + 8 * fq;
        asm volatile("" : "+v"(col0));
        u32x4 qv[2][4], qp[2]; u32x2 ga[2][4], gb[2][4];
        const int wave_ = wr * 4 + wc, lane8_ = (fq * 16 + fr) * 8;
#define MG_LOAD(K) { const int ai_ = (K) >> 1, bj_ = (K) & 1, rblk_ = rb + ai_ * HALF; const size_t o_ = (size_t)(rblk_ + fr) * 1024 + col0 + bj_ * HALF; \
        _Pragma("unroll") for (int m = 0; m < 4; ++m) { const size_t b_ = blk_index(u.pm, u.pn, wave_, ai_, bj_, m) * 512 + lane8_; \
            qv[(K) & 1][m] = *(const u32x4*)(Q + b_); ga[(K) & 1][m] = *(const u32x2*)(GA + b_); gb[(K) & 1][m] = *(const u32x2*)(GB + b_); } \
        qp[(K) & 1] = (u32x4){0u, 0u, 0u, 0u}; \
        if ((rblk_ & 8191) != 0) qp[(K) & 1] = *(const u32x4*)(Q + blk_index(wr == 0 && ai_ == 0 ? u.pm - 1 : u.pm, u.pn, wr == 1 ? wc : 4 + wc, wr == 1 ? ai_ : 1 - ai_, bj_, 3) * 512 + lane8_); }
        MG_LOAD(0)
#pragma unroll
        for (int k = 0; k < 4; ++k) { const int ai = k >> 1, bj = k & 1, rblk = rb + ai * HALF;
            const size_t off0 = (size_t)(rblk + fr) * 1024 + col0 + bj * HALF;
            if (k < 3) MG_LOAD(k + 1)
            const u32x4 pp = qp[k & 1]; float sp[8];
            sp[0] = scan_suf(bf_lo(pp.x)); sp[1] = scan_suf(bf_hi(pp.x)); sp[2] = scan_suf(bf_lo(pp.y)); sp[3] = scan_suf(bf_hi(pp.y));
            sp[4] = scan_suf(bf_lo(pp.z)); sp[5] = scan_suf(bf_hi(pp.z)); sp[6] = scan_suf(bf_lo(pp.w)); sp[7] = scan_suf(bf_hi(pp.w));
#pragma unroll
            for (int m = 0; m < 4; ++m) { const int ts = (rblk + m * 16 + fr) & 8191;
                const float inv = (ts + 1 < W) ? __builtin_amdgcn_rcpf((float)(ts + 1)) : (1.0f / W);
                const u32x4 qq = qv[k & 1][m]; const u32x2 g_a = ga[k & 1][m], g_b = gb[k & 1][m]; float x[8];
                x[0] = bf_lo(qq.x); x[1] = bf_hi(qq.x); x[2] = bf_lo(qq.y); x[3] = bf_hi(qq.y); x[4] = bf_lo(qq.z); x[5] = bf_hi(qq.z); x[6] = bf_lo(qq.w); x[7] = bf_hi(qq.w);
                f32x4 v0, v1;
#pragma unroll
                for (int e = 0; e < 4; ++e) {
                    const float p0 = pool_sum<W>(scan_pre(x[e]), sp[e]) * inv - x[e], p1 = pool_sum<W>(scan_pre(x[4 + e]), sp[4 + e]) * inv - x[4 + e];
                    sp[e] = scan_suf(x[e]); sp[4 + e] = scan_suf(x[4 + e]);
                    v0[e] = u8f(g_a.x, e) * acc[ai][bj][m][0][e] + u8f(g_b.x, e) * p0; v1[e] = u8f(g_a.y, e) * acc[ai][bj][m][1][e] + u8f(g_b.y, e) * p1; }
                *(u32x4*)(MG + off0 + m * 16384) = pack8(v0, v1); }
            asm volatile("" ::: "memory"); }
#undef MG_LOAD
    }
    __device__ __forceinline__ void operator()(const f32x4 (&acc)[2][2][4][2], const Unit& u, int wr, int wc, int fr, int fq) const {
        if (u.pn == 0) tile<2>(acc, u, wr, wc, fr, fq); else if (u.pn == 1) tile<4>(acc, u, wr, wc, fr, fq); else if (u.pn == 2) tile<8>(acc, u, wr, wc, fr, fq); else tile<16>(acc, u, wr, wc, fr, fq);
    }
};
struct EpiZ {
    static constexpr bool PERM = false, AFTER_DRAIN = false;
    const float* x; float* z; const float* mod; f32x2* statp; float alpha;
    __device__ __forceinline__ void operator()(const f32x4 (&acc)[2][2][4][2], const Unit& u, int wr, int wc, int fr, int fq) const {
        const int row0 = u.pm * BM + wr * 64 + fr, b = (u.pm * BM) >> 13; int col0 = u.pn * BM + wc * 32 + 4 * fq;
        asm volatile("" : "+v"(col0));
        f32x4 gv[2][2];
#pragma unroll
        for (int bj = 0; bj < 2; ++bj)
#pragma unroll
            for (int n = 0; n < 2; ++n) gv[bj][n] = *(const f32x4*)(mod + b * 6144 + 2048 + col0 + bj * HALF + n * 16) + 1.0f;
        const int rowb = u.pm * BM + wr * 64, rsub = fr & 7, colx = col0 + 16 * (fr >> 3);
        f32x4 xl[3][2], xh[3][2];
#define Z_LOAD(K) { const size_t off_ = (size_t)(rowb + ((K) >> 2) * HALF + ((K) & 3) * 16 + rsub) * 1024 + colx; \
        _Pragma("unroll") for (int bj = 0; bj < 2; ++bj) { xl[(K) % 3][bj] = *(const f32x4*)(x + off_ + bj * HALF); xh[(K) % 3][bj] = *(const f32x4*)(x + off_ + 8 * 1024 + bj * HALF); } }
        Z_LOAD(0) Z_LOAD(1)
#pragma unroll
        for (int k = 0; k < 8; ++k) { const int ai = k >> 2, m = k & 3, row = row0 + ai * HALF + m * 16; const size_t off = (size_t)(rowb + ai * HALF + m * 16 + rsub) * 1024 + colx; float s = 0.f, q = 0.f;
            if (k < 6) Z_LOAD(k + 2)
#pragma unroll
            for (int bj = 0; bj < 2; ++bj) { const f32x4 XL = xl[k % 3][bj], XH = xh[k % 3][bj]; f32x4 x0, x1, ZL, ZH;
#pragma unroll
                for (int e = 0; e < 4; ++e) { x0[e] = dpp_fill<0x118>(XL[e], XH[e]); x1[e] = dpp_fill<0x108>(XH[e], XL[e]); }
                const f32x4 z0 = x0 * alpha + gv[bj][0] * acc[ai][bj][m][0], z1 = x1 * alpha + gv[bj][1] * acc[ai][bj][m][1];
                s += ((z0[0] + z0[1]) + (z0[2] + z0[3])) + ((z1[0] + z1[1]) + (z1[2] + z1[3]));
                q += ((z0[0] * z0[0] + z0[1] * z0[1]) + (z0[2] * z0[2] + z0[3] * z0[3])) + ((z1[0] * z1[0] + z1[1] * z1[1]) + (z1[2] * z1[2] + z1[3] * z1[3]));
#pragma unroll
                for (int e = 0; e < 4; ++e) { ZL[e] = dpp_fill<0x118>(z0[e], z1[e]); ZH[e] = dpp_fill<0x108>(z1[e], z0[e]); }
                *(f32x4*)(z + off + bj * HALF) = ZL; *(f32x4*)(z + off + 8 * 1024 + bj * HALF) = ZH; }
            s += __shfl_xor(s, 16); s += __shfl_xor(s, 32); q += __shfl_xor(q, 16); q += __shfl_xor(q, 32);
            if (fq == 0) statp[(size_t)row * 16 + u.pn * 4 + wc] = (f32x2){s, q};
            asm volatile("" ::: "memory"); }
#undef Z_LOAD
    }
};
__device__ __forceinline__ unsigned pk4_fp8(float a, float b, float c, float d) { int r = 0; r = __builtin_amdgcn_cvt_pk_fp8_f32(a, b, r, false); r = __builtin_amdgcn_cvt_pk_fp8_f32(c, d, r, true); return (unsigned)r; }
constexpr float W8_SCALE = 64.0f, ACT8_SCALE = 8.0f;
struct EpiGU {
    static constexpr bool PERM = true, AFTER_DRAIN = false;
    unsigned char* ACT;
    __device__ __forceinline__ void operator()(const f32x4 (&acc)[2][2][4][2], const Unit& u, int wr, int wc, int fr, int fq) const {
        const int row0 = u.pm * BM + wr * 64 + fr, col0 = (u.pn & 3) * 128 + wc * 32 + 8 * fq;
        const float is = 1.0f / W8_SCALE, os = ACT8_SCALE / W8_SCALE;
#pragma unroll
        for (int ai = 0; ai < 2; ++ai) { if (ai == 1 && u.hm) break;
#pragma unroll
            for (int m = 0; m < 4; ++m) { unsigned char* rowp = ACT + (size_t)(row0 + ai * HALF + m * 16) * 512 + col0; f32x4 v0, v1;
#pragma unroll
                for (int j = 0; j < 4; ++j) { const float g0 = acc[ai][0][m][0][j] * is, g1 = acc[ai][0][m][1][j] * is;
                    v0[j] = __builtin_fminf(__builtin_fmaxf(g0 * sigmoidf_(g0) * acc[ai][1][m][0][j] * os, -448.0f), 448.0f); v1[j] = __builtin_fminf(__builtin_fmaxf(g1 * sigmoidf_(g1) * acc[ai][1][m][1][j] * os, -448.0f), 448.0f); }
                *(u32x2*)rowp = (u32x2){pk4_fp8(v0[0], v0[1], v0[2], v0[3]), pk4_fp8(v1[0], v1[1], v1[2], v1[3])}; } }
    }
};
struct EpiDown {
    static constexpr bool PERM = true, AFTER_DRAIN = false;
    bf16_t* O; const PG8_LAS u32x2* rs;
    __device__ __forceinline__ void operator()(const f32x4 (&acc)[2][2][4][2], const Unit& u, int wr, int wc, int fr, int fq) const {
        asm volatile("" : "+v"(fr), "+v"(fq));
        const int colx = (u.pn & 3) * 256 + wc * 64 + 32 * (fr >> 3) + 8 * fq;
        const PG8_LAS unsigned* tb = (const PG8_LAS unsigned*)(rs + u.ord * 256 + wr * 64);
#pragma unroll
        for (int ai = 0; ai < 2; ++ai) { if (ai == 1 && u.hm) break;
#pragma unroll
            for (int m = 0; m < 4; ++m) { const int rb = ai * HALF + m * 16;
                const float wt = __builtin_bit_cast(float, tb[(rb + fr) * 2 + 1]) * (1.0f / (W8_SCALE * ACT8_SCALE));
                const int slo = (int)tb[(rb + (fr & 7)) * 2], shi = (int)tb[(rb + 8 + (fr & 7)) * 2];
                const u32x4 p0 = pack8(acc[ai][0][m][0] * wt, acc[ai][0][m][1] * wt), p1 = pack8(acc[ai][1][m][0] * wt, acc[ai][1][m][1] * wt);
                u32x4 sl, sh;
                sl.x = dpp_fillu<0x118>(p0.x, p1.x); sl.y = dpp_fillu<0x118>(p0.y, p1.y); sl.z = dpp_fillu<0x118>(p0.z, p1.z); sl.w = dpp_fillu<0x118>(p0.w, p1.w);
                sh.x = dpp_fillu<0x108>(p1.x, p0.x); sh.y = dpp_fillu<0x108>(p1.y, p0.y); sh.z = dpp_fillu<0x108>(p1.z, p0.z); sh.w = dpp_fillu<0x108>(p1.w, p0.w);
                if (slo >= 0) *(u32x4*)(O + (size_t)slo * 1024 + colx) = sl;
                if (shi >= 0) *(u32x4*)(O + (size_t)shi * 1024 + colx) = sh; } }
    }
};
struct MoeOrder {
    int G, vc, nunits, nfull; const PG8_LAS int* tinfo;
    __device__ __forceinline__ bool next(int i, Unit& u) const { const int L = i * G + vc; if (L >= nunits) return false; const int k = L >> 2, ti = tinfo[k];
        u.pm = ti & 0xffff; u.pn = (ti >> 16) * 4 + (L & 3); u.ord = i; u.hm = k >= nfull ? 1 : 0; return true; }
    __device__ __forceinline__ void a_ready(const Unit&) const {}
    __device__ __forceinline__ void done(const Unit&) const {}
};

struct NoPost { __device__ __forceinline__ void operator()(int) const {} };
typedef int i32x8 __attribute__((ext_vector_type(8))); typedef int i32x4 __attribute__((ext_vector_type(4)));
template <class Epi, class Sched, bool ALIGN_EPI = false, bool SP2 = false, bool GATHER = false, class Post = NoPost, bool FP8 = false>
__device__ __forceinline__ void gemm_phase(PG8_LAS unsigned char* lds, const Gemm g, const Sched& S, const Epi& E, const PG8_LAS unsigned short* toks = nullptr, const Post& PP = Post()) {
    static_assert(!GATHER || SP2, "gather is written for the SP2 loop only");
    int tid = threadIdx.x; asm volatile("" : "+v"(tid));
    const int wid = __builtin_amdgcn_readfirstlane(tid >> 6), lane = tid & 63, wr = wid >> 2, wc = wid & 3, fr = lane & 15, fq = lane >> 4;
    const int K = g.K, nt = K / BK;
    unsigned voffA[2], voffB[2];
#pragma unroll
    for (int i = 0; i < 2; ++i) { int R, C; stage_rc(tid * 16 + i * 8192, R, C); const int Rb = Epi::PERM ? ((R & ~31) + perm32(R & 31)) : R;
        voffA[i] = (unsigned)(R * K + C) * 2u; voffB[i] = (unsigned)(Rb * K + C) * 2u; }
    const size_t kstep = (size_t)(BK * 2);
    const size_t hstep = (size_t)HALF * K * 2;
    const size_t tstep = 2 * hstep;
    const unsigned ldsw = (unsigned)wid * 1024u;
    const int aoff = lds_byte(wr * 64 + fr, fq * 8), boff = lds_byte(wc * 32 + fr, fq * 8);
#define PG8_SA(b, h) (((b) * 2 + (h)) * HTB)
#define PG8_SB(b, h) ((4 + (b) * 2 + (h)) * HTB)
    const __amdgpu_buffer_rsrc_t rsA = __builtin_amdgcn_make_buffer_rsrc((void*)g.A, 0, (int)0xFFFFFFF0u, 0x00020000), rsB = __builtin_amdgcn_make_buffer_rsrc((void*)g.Bt, 0, (int)0xFFFFFFF0u, 0x00020000);
#define PG8_STAGE_X(rs, base, bufoff, gbase, voff) do { const unsigned _so = (unsigned)((const char*)(gbase) - (const char*)(base)); _Pragma("unroll") for (int _i = 0; _i < 2; ++_i) \
        __builtin_amdgcn_raw_ptr_buffer_load_lds(rs, (PG8_LAS unsigned*)(lds + (bufoff) + ldsw + _i * 8192), 16, (voff)[_i], _so, 0, 0); } while (0)
#define PG8_STAGE_A(bufoff, gbase) PG8_STAGE_X(rsA, g.A, bufoff, gbase, voffA)
#define PG8_STAGE_B(bufoff, gbase) PG8_STAGE_X(rsB, g.Bt, bufoff, gbase, voffB)
    unsigned vAc[2][2];
#define PG8_TOKL(j, h, _i) ({ int _R2, _C2; stage_rc(tid * 16 + (_i) * 8192, _R2, _C2); (unsigned)toks[(j) * BM + (h) * HALF + _R2] * (unsigned)(K * 2) + (unsigned)(_C2 * 2); })
#define PG8_STAGE_G(bufoff, kb, v, h) do { _Pragma("unroll") for (int _i = 0; _i < 2; ++_i) \
        __builtin_amdgcn_raw_ptr_buffer_load_lds(rsA, (PG8_LAS unsigned*)(lds + (bufoff) + ldsw + _i * 8192), 16, (v)[h][_i], (unsigned)(kb), 0, 0); } while (0)
#define PG8_STAGE_G2(bufoff, kb, h) do { _Pragma("unroll") for (int _i = 0; _i < 2; ++_i) { unsigned _o = vAc[h][_i]; if (last) _o = PG8_TOKL(has_next ? ui + 1 : ui, h, _i); \
        __builtin_amdgcn_raw_ptr_buffer_load_lds(rsA, (PG8_LAS unsigned*)(lds + (bufoff) + ldsw + _i * 8192), 16, _o, (unsigned)(kb), 0, 0); } } while (0)
#define PG8_LDA(dst, b, h) do { if constexpr (FP8) { _Pragma("unroll") for (int m = 0; m < 4; ++m) { const i32x4 _lo = *(const PG8_LAS i32x4*)(lds + PG8_SA(b, h) + aoff + m * 2048), _hi = *(const PG8_LAS i32x4*)(lds + PG8_SA(b, h) + aoff + m * 2048 + 1024); \
            dst##8[m] = __builtin_shufflevector(_lo, _hi, 0, 1, 2, 3, 4, 5, 6, 7); } } \
        else { _Pragma("unroll") for (int m = 0; m < 4; ++m) _Pragma("unroll") for (int k = 0; k < 2; ++k) dst[m][k] = *(const PG8_LAS bf16x8*)(lds + PG8_SA(b, h) + aoff + m * 2048 + k * 1024); } } while (0)
#define PG8_LDB(dst, b, h) do { if constexpr (FP8) { _Pragma("unroll") for (int n = 0; n < 2; ++n) { const i32x4 _lo = *(const PG8_LAS i32x4*)(lds + PG8_SB(b, h) + boff + n * 2048), _hi = *(const PG8_LAS i32x4*)(lds + PG8_SB(b, h) + boff + n * 2048 + 1024); \
            dst##8[n] = __builtin_shufflevector(_lo, _hi, 0, 1, 2, 3, 4, 5, 6, 7); } } \
        else { _Pragma("unroll") for (int n = 0; n < 2; ++n) _Pragma("unroll") for (int k = 0; k < 2; ++k) dst[n][k] = *(const PG8_LAS bf16x8*)(lds + PG8_SB(b, h) + boff + n * 2048 + k * 1024); } } while (0)
#define PG8_MMA(ai, bj, At, Bt) do { __builtin_amdgcn_s_setprio(1); \
        if constexpr (FP8) { _Pragma("unroll") for (int m = 0; m < 4; ++m) _Pragma("unroll") for (int n = 0; n < 2; ++n) \
            acc[ai][bj][m][n] = __builtin_amdgcn_mfma_scale_f32_16x16x128_f8f6f4(Bt##8[n], At##8[m], acc[ai][bj][m][n], 0, 0, 0, 0, 0, 0); } \
        else { _Pragma("unroll") for (int m = 0; m < 4; ++m) _Pragma("unroll") for (int n = 0; n < 2; ++n) _Pragma("unroll") for (int k = 0; k < 2; ++k) \
            acc[ai][bj][m][n] = __builtin_amdgcn_mfma_f32_16x16x32_bf16(Bt[n][k], At[m][k], acc[ai][bj][m][n], 0, 0, 0); } \
        __builtin_amdgcn_s_setprio(0); } while (0)
#define PG8_WAIT_V(n) asm volatile("s_waitcnt vmcnt(" #n ")" ::: "memory")
#define PG8_WAIT_L(n) asm volatile("s_waitcnt lgkmcnt(" #n ")" ::: "memory")
#define PG8_BAR __builtin_amdgcn_s_barrier()
#define PG8_SCHED __builtin_amdgcn_sched_barrier(0)
    Unit cur, nxt; int ui = 0;
    if (!S.next(0, cur)) return;
    f32x4 acc[2][2][4][2];
#pragma unroll
    for (int a = 0; a < 2; ++a)
#pragma unroll
        for (int b = 0; b < 2; ++b)
#pragma unroll
            for (int m = 0; m < 4; ++m)
#pragma unroll
                for (int n = 0; n < 2; ++n) acc[a][b][m][n] = (f32x4){0.f, 0.f, 0.f, 0.f};
    bf16x8 At[4][2], B0[2][2], B1[2][2]; i32x8 At8[4], B08[2], B18[2];
    const char* cA = (const char*)g.A + (size_t)cur.pm * tstep; const char* cB = (const char*)g.Bt + (size_t)cur.pn * tstep;
    S.a_ready(cur);
    if constexpr (SP2) {
        if constexpr (GATHER) {
#pragma unroll
            for (int _h = 0; _h < 2; ++_h) { vAc[_h][0] = PG8_TOKL(0, _h, 0); vAc[_h][1] = PG8_TOKL(0, _h, 1); }
            PG8_STAGE_B(PG8_SB(0, 0), cB); PG8_STAGE_B(PG8_SB(0, 1), cB + hstep); PG8_STAGE_G(PG8_SA(0, 0), 0, vAc, 0); PG8_STAGE_G(PG8_SA(0, 1), 0, vAc, 1);
        } else {
        PG8_STAGE_B(PG8_SB(0, 0), cB); PG8_STAGE_B(PG8_SB(0, 1), cB + hstep); PG8_STAGE_A(PG8_SA(0, 0), cA); PG8_STAGE_A(PG8_SA(0, 1), cA + hstep);
        }
        if (wr == 1) PG8_BAR;
        PG8_WAIT_V(2); PG8_BAR;
        if constexpr (GATHER) { PG8_STAGE_B(PG8_SB(1, 0), cB + kstep); PG8_STAGE_G(PG8_SA(1, 0), kstep, vAc, 0); PG8_STAGE_B(PG8_SB(1, 1), cB + hstep + kstep); }
        else {
        PG8_STAGE_B(PG8_SB(1, 0), cB + kstep); PG8_STAGE_A(PG8_SA(1, 0), cA + kstep); PG8_STAGE_B(PG8_SB(1, 1), cB + hstep + kstep);
        }
        PG8_WAIT_V(6); PG8_BAR;
    } else {
        PG8_STAGE_B(PG8_SB(0, 0), cB); PG8_STAGE_A(PG8_SA(0, 0), cA); PG8_STAGE_B(PG8_SB(0, 1), cB + hstep); PG8_STAGE_A(PG8_SA(0, 1), cA + hstep);
        if (wr == 1) PG8_BAR;
        PG8_WAIT_V(4); PG8_BAR;
        PG8_STAGE_B(PG8_SB(1, 0), cB + kstep); PG8_STAGE_A(PG8_SA(1, 0), cA + kstep); PG8_STAGE_B(PG8_SB(1, 1), cB + hstep + kstep);
        PG8_WAIT_V(6); PG8_BAR;
    }
    for (;;) {
        const bool has_next = S.next(ui + 1, nxt);
        const char* nA = has_next ? (const char*)g.A + (size_t)nxt.pm * tstep : cA; const char* nB = has_next ? (const char*)g.Bt + (size_t)nxt.pn * tstep : cB;
#pragma clang loop unroll(disable)
        for (int t = 0; t < nt; t += 2) {
            const bool last = (t == nt - 2);
            const char* a1 = cA + (size_t)(t + 1) * kstep;
            const char* a2 = last ? nA : cA + (size_t)(t + 2) * kstep; const char* b2 = last ? nB : cB + (size_t)(t + 2) * kstep;
            const char* a3 = a2 + kstep; const char* b3 = b2 + kstep;
            if (last && has_next) S.a_ready(nxt);
            const size_t kb2 = last ? (size_t)0 : (size_t)(t + 2) * kstep;
            if constexpr (SP2) {
            PG8_LDB(B0, 0, 0); PG8_LDB(B1, 0, 1); PG8_SCHED; PG8_LDA(At, 0, 0); if constexpr (GATHER) PG8_STAGE_G(PG8_SA(1, 1), (size_t)(t + 1) * kstep, vAc, 1); else PG8_STAGE_A(PG8_SA(1, 1), a1 + hstep);
            PG8_WAIT_V(8); PG8_WAIT_L(0); PG8_BAR; PG8_MMA(0, 0, At, B0); PG8_MMA(0, 1, At, B1); PG8_BAR; PG8_SCHED;
            if (!cur.hm) PG8_LDA(At, 0, 1); PG8_STAGE_B(PG8_SB(0, 0), b2); PG8_STAGE_B(PG8_SB(0, 1), b2 + hstep); if constexpr (GATHER) PG8_STAGE_G2(PG8_SA(0, 0), kb2, 0); else PG8_STAGE_A(PG8_SA(0, 0), a2);
            PG8_WAIT_V(8); PG8_WAIT_L(0); PG8_BAR; if (!cur.hm) { PG8_MMA(1, 0, At, B0); PG8_MMA(1, 1, At, B1); } PG8_BAR; PG8_SCHED;
            PG8_LDB(B0, 1, 0); PG8_LDB(B1, 1, 1); PG8_SCHED; PG8_LDA(At, 1, 0); if constexpr (GATHER) PG8_STAGE_G2(PG8_SA(0, 1), kb2, 1); else PG8_STAGE_A(PG8_SA(0, 1), a2 + hstep);
            PG8_WAIT_V(8); PG8_WAIT_L(0); PG8_BAR; PG8_MMA(0, 0, At, B0); PG8_MMA(0, 1, At, B1); PG8_BAR; PG8_SCHED;
            if (!cur.hm) PG8_LDA(At, 1, 1); PG8_STAGE_B(PG8_SB(1, 0), b3); PG8_STAGE_B(PG8_SB(1, 1), b3 + hstep); if constexpr (GATHER) PG8_STAGE_G2(PG8_SA(1, 0), kb2 + kstep, 0); else PG8_STAGE_A(PG8_SA(1, 0), a3);
            PG8_WAIT_V(8); PG8_WAIT_L(0); PG8_BAR; if (!cur.hm) { PG8_MMA(1, 0, At, B0); PG8_MMA(1, 1, At, B1); } PG8_BAR; PG8_SCHED;
            } else {
            PG8_LDB(B0, 0, 0); PG8_SCHED; PG8_LDA(At, 0, 0); PG8_STAGE_A(PG8_SA(1, 1), a1 + hstep);
            PG8_WAIT_L(8); PG8_BAR; PG8_WAIT_L(0); PG8_MMA(0, 0, At, B0); PG8_BAR; PG8_SCHED;
            PG8_LDB(B1, 0, 1); PG8_STAGE_B(PG8_SB(0, 0), b2);
            PG8_BAR; PG8_WAIT_L(0); PG8_MMA(0, 1, At, B1); PG8_BAR;
            PG8_LDA(At, 0, 1); PG8_STAGE_A(PG8_SA(0, 0), a2);
            PG8_BAR; PG8_WAIT_L(0); PG8_MMA(1, 0, At, B0); PG8_BAR; PG8_SCHED;
            PG8_STAGE_B(PG8_SB(0, 1), b2 + hstep);
            PG8_WAIT_V(6); PG8_BAR; PG8_MMA(1, 1, At, B1); PG8_BAR;
            PG8_LDB(B0, 1, 0); PG8_SCHED; PG8_LDA(At, 1, 0); PG8_STAGE_A(PG8_SA(0, 1), a2 + hstep);
            PG8_WAIT_L(8); PG8_BAR; PG8_WAIT_L(0); PG8_MMA(0, 0, At, B0); PG8_BAR; PG8_SCHED;
            PG8_LDB(B1, 1, 1); PG8_STAGE_B(PG8_SB(1, 0), b3);
            PG8_BAR; PG8_WAIT_L(0); PG8_MMA(0, 1, At, B1); PG8_BAR;
            PG8_LDA(At, 1, 1); PG8_STAGE_A(PG8_SA(1, 0), a3);
            PG8_BAR; PG8_WAIT_L(0); PG8_MMA(1, 0, At, B0); PG8_BAR; PG8_SCHED;
            PG8_STAGE_B(PG8_SB(1, 1), b3 + hstep);
            PG8_WAIT_V(6); PG8_BAR; PG8_MMA(1, 1, At, B1); PG8_BAR;
            }
        }
        if constexpr (ALIGN_EPI) { if (wr == 0) PG8_BAR; }
        if constexpr (!Epi::AFTER_DRAIN) { E(acc, cur, wr, wc, fr, fq); S.done(cur); }
        PP(ui);
        if (!has_next) break;
#pragma unroll
        for (int a = 0; a < 2; ++a)
#pragma unroll
            for (int b = 0; b < 2; ++b)
#pragma unroll
                for (int m = 0; m < 4; ++m)
#pragma unroll
                    for (int n = 0; n < 2; ++n) acc[a][b][m][n] = (f32x4){0.f, 0.f, 0.f, 0.f};
        cur = nxt; cA = nA; cB = nB; ++ui;
        if constexpr (GATHER) {
#pragma unroll
            for (int _h = 0; _h < 2; ++_h) { vAc[_h][0] = PG8_TOKL(ui, _h, 0); vAc[_h][1] = PG8_TOKL(ui, _h, 1); } }
        if constexpr (ALIGN_EPI) { if (wr == 1) PG8_BAR; }
    }
    PG8_WAIT_V(0);
    if constexpr (!ALIGN_EPI) { if (wr == 0) PG8_BAR; }
    PG8_BAR;
    if constexpr (Epi::AFTER_DRAIN) { E.fused(acc, cur, wr, wc, fr, fq, lds, wid, lane); S.done(cur); }
#undef PG8_SA
#undef PG8_SB
#undef PG8_STAGE_X
#undef PG8_STAGE_A
#undef PG8_STAGE_B
#undef PG8_STAGE_G
#undef PG8_STAGE_G2
#undef PG8_TOKL
#undef PG8_LDA
#undef PG8_LDB
#undef PG8_MMA
#undef PG8_WAIT_V
#undef PG8_WAIT_L
#undef PG8_BAR
#undef PG8_SCHED
}
}

#define GAS __attribute__((address_space(1)))
#define LAS __attribute__((address_space(3)))
typedef unsigned short bf16;
typedef unsigned v4u __attribute__((ext_vector_type(4)));
typedef unsigned v2u __attribute__((ext_vector_type(2)));
typedef float f32x4 __attribute__((ext_vector_type(4)));
typedef float f32x2 __attribute__((ext_vector_type(2)));
typedef short bf16x8 __attribute__((ext_vector_type(8)));
typedef GAS unsigned gu32;
#define RLX_AGENT __ATOMIC_RELAXED, __HIP_MEMORY_SCOPE_AGENT
#define LDS_WAIT() asm volatile("s_waitcnt lgkmcnt(0)" ::: "memory")
#define VM_WAIT() asm volatile("s_waitcnt vmcnt(0)" ::: "memory")
__device__ __forceinline__ unsigned f2bf(float f) { unsigned u = __builtin_bit_cast(unsigned, f); return (u + 0x7fffu + ((u >> 16) & 1u)) >> 16; }
__device__ __forceinline__ unsigned pk2(float lo, float hi) { return f2bf(lo) | (f2bf(hi) << 16); }
__device__ __forceinline__ float bflo(unsigned w) { return __builtin_bit_cast(float, w << 16); }
__device__ __forceinline__ float bfhi(unsigned w) { return __builtin_bit_cast(float, w & 0xffff0000u); }
__device__ __forceinline__ float wave_sum(float v) {
#pragma unroll
    for (int o = 1; o < 64; o <<= 1) v += __shfl_xor(v, o);
    return v;
}

#define XB_TMO      128
#define XB_XCNT(j)  (256  + 64 * (j))
#define XB_XSUB(j)  (1280 + 64 * (j))
#define XB_XGEN(j)  (2304 + 64 * (j))
#define XB_TOP      3328
#define XB_TOPGEN   3392
#define XCD_BAR_WORDS 3456
#define XB_SPIN_CAP (1u << 18)

__device__ __forceinline__ unsigned xb_ld(unsigned* p)              { return __hip_atomic_load(p, __ATOMIC_RELAXED, __HIP_MEMORY_SCOPE_AGENT); }
__device__ __forceinline__ unsigned xb_add(unsigned* p, unsigned v) { return __hip_atomic_fetch_add(p, v, __ATOMIC_RELAXED, __HIP_MEMORY_SCOPE_AGENT); }
__device__ __forceinline__ unsigned xb_xcc_id() { return (unsigned)__builtin_amdgcn_s_getreg((3 << 11) | 20) & 0xFu; }
#define XB_SPIN(cond, bar) do { unsigned _sp = 0; while (cond) { __builtin_amdgcn_s_sleep(1); \
    if ((++_sp & 255u) == 0u) { if (xb_ld(&(bar)[XB_TMO])) break; if (_sp > XB_SPIN_CAP) { atomicAdd(&(bar)[XB_TMO], 1u); break; } } } } while (0)

struct XcdBarrier {
    unsigned* bar; unsigned x;
    volatile LAS unsigned* st;
};

__device__ __forceinline__ XcdBarrier xcd_barrier_post(unsigned* bar, volatile LAS unsigned* st) {
    XcdBarrier b; b.bar = bar; b.x = xb_xcc_id(); b.st = st;
    if (threadIdx.x == 0) (void)xb_add(&bar[XB_XCNT(b.x)], 1u);
    return b;
}
__device__ __forceinline__ void xcd_barrier_complete(unsigned* bar, unsigned x, unsigned& nloc, unsigned& nx) {
    const unsigned G = gridDim.x * gridDim.y * gridDim.z;
    unsigned sum, cnt, mine, sp = 0u;
    for (;;) {
        sum = 0u; cnt = 0u; mine = 0u;
#pragma unroll
        for (unsigned j = 0; j < 16; ++j) { const unsigned c = xb_ld(&bar[XB_XCNT(j)]); sum += c; cnt += (c > 0u) ? 1u : 0u; mine = (j == x) ? c : mine; }
        if (sum == G) break;
        __builtin_amdgcn_s_sleep(1);
        if ((++sp & 255u) == 0u) { if (xb_ld(&bar[XB_TMO])) break; if (sp > XB_SPIN_CAP) { atomicAdd(&bar[XB_TMO], 1u); break; } }
    }
    nloc = mine > 0u ? mine : 1u; nx = cnt > 0u ? cnt : 1u;
}

__device__ __forceinline__ void xcd_barrier(const XcdBarrier& b) {
    asm volatile("s_waitcnt vmcnt(0)" ::: "memory");
    __syncthreads();
    if (threadIdx.x == 0) {
        unsigned* bar = b.bar;
        __builtin_amdgcn_s_waitcnt(0);
        unsigned nloc = b.st[0], nx = b.st[1];
        if (nloc == 0u) { xcd_barrier_complete(bar, b.x, nloc, nx); b.st[0] = nloc; b.st[1] = nx; }
        const unsigned old = xb_add(&bar[XB_XSUB(b.x)], 1u);
        const unsigned gen = old / nloc;
        if (old + 1u == (gen + 1u) * nloc) {
            __builtin_amdgcn_fence(__ATOMIC_RELEASE, "agent");
            asm volatile("s_waitcnt vmcnt(0)" ::: "memory");
            const unsigned og = xb_add(&bar[XB_TOP], 1u);
            const unsigned tg = og / nx;
            if (og + 1u == (tg + 1u) * nx) xb_add(&bar[XB_TOPGEN], 1u);
            else XB_SPIN(xb_ld(&bar[XB_TOPGEN]) == tg, bar);
            __builtin_amdgcn_fence(__ATOMIC_ACQUIRE, "agent");
            xb_add(&bar[XB_XGEN(b.x)], 1u);
            asm volatile("s_waitcnt vmcnt(0)" ::: "memory");
        } else {
            XB_SPIN(xb_ld(&bar[XB_XGEN(b.x)]) == gen, bar);
            __builtin_amdgcn_fence(__ATOMIC_ACQUIRE, "agent");
            asm volatile("s_waitcnt vmcnt(0)" ::: "memory");
        }
    }
    __syncthreads();
}

constexpr int NWAVES = 8;
constexpr int D = 1024, NBATCH = 4, T = 8192, M = NBATCH * T;
constexpr int NPROJ = 6144, NE = 64, DE = 512;
constexpr int CAP = 2 * M + NE * 256;
constexpr int NBLK = M / 128;
constexpr float LN_EPS = 1e-5f;
constexpr float ALPHA = 1.18920711500272f;
constexpr size_t MiB = 1u << 20;
constexpr size_t WS_CTL = 0, CTL_ZERO_BYTES = 65536;
constexpr int NKC = 8;
constexpr size_t WS_MODP = 96 * MiB;
constexpr size_t WS_MOD = 1 * MiB + 512 * 1024;
constexpr size_t WS_GCBC = 1 * MiB + 768 * 1024;
constexpr size_t WS_RW = 2 * MiB;
constexpr size_t WS_WGCNT = 2 * MiB + 512 * 1024;
constexpr size_t WS_TOKINFO = 3 * MiB;
constexpr size_t WS_ROWSLOT = 3 * MiB + 512 * 1024;
constexpr size_t WS_ROWWT = 4 * MiB;
constexpr size_t WS_ROWTOK = 4 * MiB + 512 * 1024;
constexpr size_t WS_STATP = 5 * MiB;
constexpr size_t WS_RAW = 26 * MiB;
constexpr size_t WS_WIN = 10 * MiB, WS_WOC = 22 * MiB, WS_WO = 24 * MiB, WS_WGU = 32 * MiB, WS_WD = 160 * MiB;
constexpr size_t WS_U = 224 * MiB, WS_A2 = WS_U, WS_H = WS_U;
constexpr size_t WS_Q = 288 * MiB, WS_MG = 480 * MiB;
constexpr size_t WS_GA = 352 * MiB, WS_GB = 416 * MiB, WS_PQG = 480 * MiB;
constexpr size_t WS_ACT = 480 * MiB, WS_O = 352 * MiB;
constexpr size_t WS_END = 560 * MiB;
static_assert(WS_ACT + (size_t)CAP * DE * 2 <= 560 * MiB && WS_O + (size_t)2 * M * D * 2 <= WS_ACT, "d_ws map");
constexpr int CW_TMO = 0, CW_BAR = 1024;
constexpr int RING_OFF = 0, RING_BYTES = 131072;
constexpr int MISC_OFF = 135168;
constexpr int LT_PADSTART = MISC_OFF + 128;
constexpr int LT_TILEE = MISC_OFF + 512;
constexpr int LT_HIST = MISC_OFF + 2048;
constexpr int LT_TOT = MISC_OFF + 2304, LT_BASE = MISC_OFF + 2560;
constexpr int LT_AE = MISC_OFF + 3072, LT_APOS = MISC_OFF + 4096;
constexpr int LT_PSUM = MISC_OFF + 5120;
constexpr int LT_CONVW = 147456;
constexpr int LDS_BYTES = 159744;
static_assert(LT_PSUM + 4096 <= LDS_BYTES && LT_HIST + 5 * 256 * 8 <= LDS_BYTES, "LDS map");

struct Frame {
    LAS unsigned char* lds; unsigned char* ldsg;
    gu32* ctl;
    int tid, lane, wave, G;
    const float *x, *c, *w_ada, *b_ada, *w_in, *conv_w, *w_out_conv, *w_pool, *pool_scale, *w_o, *ln1_g, *ln1_b, *w_group, *b_group, *w_router, *b_router, *w_gate, *w_up, *w_down, *ln2_g, *ln2_b;
    float* out; unsigned char* ws;
};

__device__ __forceinline__ void p0a_mod(Frame& F) {
    LAS float* sc = (LAS float*)(F.lds);
    LAS float* red = (LAS float*)(F.lds + 16384);
    float* modp = (float*)(F.ws + WS_MODP);
    float w[3][16];
#pragma unroll
    for (int r = 0; r < 3; ++r) { const int u = blockIdx.x + r * F.G; if (u < NKC * 96) { const int cg = u >> 3, kc = u & 7;
        const float* wp = F.w_ada + (size_t)(kc * 128 + F.wave * 16) * NPROJ + cg * 64 + F.lane;
#pragma unroll
        for (int i = 0; i < 16; ++i) w[r][i] = __builtin_nontemporal_load(wp + (size_t)i * NPROJ); } }
    { float cv[8];
#pragma unroll
      for (int i = 0; i < 8; ++i) cv[i] = F.c[F.tid + 512 * i];
#pragma unroll
      for (int i = 0; i < 8; ++i) sc[F.tid + 512 * i] = cv[i] / (1.0f + __expf(-cv[i])); }
    __syncthreads();
#pragma unroll
    for (int r = 0; r < 3; ++r) { const int u = blockIdx.x + r * F.G; if (u >= NKC * 96) break;
        const int cg = u >> 3, kc = u & 7, k0 = kc * 128 + F.wave * 16;
        float a0 = 0.f, a1 = 0.f, a2 = 0.f, a3 = 0.f;
#pragma unroll
        for (int i = 0; i < 16; ++i) { const int k = k0 + i; a0 += sc[k] * w[r][i]; a1 += sc[1024 + k] * w[r][i]; a2 += sc[2048 + k] * w[r][i]; a3 += sc[3072 + k] * w[r][i]; }
        red[(F.wave * 4 + 0) * 64 + F.lane] = a0; red[(F.wave * 4 + 1) * 64 + F.lane] = a1; red[(F.wave * 4 + 2) * 64 + F.lane] = a2; red[(F.wave * 4 + 3) * 64 + F.lane] = a3;
        __syncthreads();
        if (F.wave < 4) { float s = 0.f;
#pragma unroll
            for (int w8 = 0; w8 < 8; ++w8) s += red[(w8 * 4 + F.wave) * 64 + F.lane];
            modp[((size_t)kc * 4 + F.wave) * NPROJ + cg * 64 + F.lane] = s; }
        __syncthreads();
    }
}

__device__ __forceinline__ int conv_row(int tau, int c) { return 128 * (tau >> 1) + 32 * (c >> 4) + 8 * ((c >> 2) & 3) + 4 * (tau & 1) + (c & 3); }
__device__ __forceinline__ void transpose_item(const float* W, int ld, int src_col0, bf16* dst, int K, int dst_row0, int k0, LAS float* scr, int lane, int tau = -1) {
    float tv[64]; const float* wsrc = W + (size_t)k0 * ld + src_col0 + lane;
#pragma unroll
    for (int i = 0; i < 64; ++i) tv[i] = wsrc[(size_t)i * ld];
#pragma unroll
    for (int i = 0; i < 64; ++i) scr[i * 65 + lane] = tv[i];
    LDS_WAIT(); asm volatile("" ::: "memory");
    const int c = lane & 7, nn = lane >> 3;
#pragma unroll
    for (int j = 0; j < 8; ++j) { const int n = nn + 8 * j; const LAS float* s = scr + (8 * c) * 65 + n;
        v4u o; o.x = pk2(s[0 * 65], s[1 * 65]); o.y = pk2(s[2 * 65], s[3 * 65]); o.z = pk2(s[4 * 65], s[5 * 65]); o.w = pk2(s[6 * 65], s[7 * 65]);
        const int drow = dst_row0 + (tau < 0 ? n : conv_row(tau, n));
        *(GAS v4u*)(dst + (size_t)drow * K + k0 + 8 * c) = o; }
    LDS_WAIT(); asm volatile("" ::: "memory");
}
constexpr int NT_ITEMS = 1280 + 256 + 256;
__device__ __forceinline__ void p0b_transpose(Frame& F, int it, LAS float* scr) {
    bf16* WinT = (bf16*)(F.ws + WS_WIN);
    if (it < 1280) { const int seg = it >> 8, r = it & 255, kb = r >> 4, nb = r & 15;
        if (seg < 4) transpose_item(F.w_in, NPROJ, (seg == 0 ? 0 : seg == 1 ? 2048 : seg == 2 ? 1024 : 4096) + 64 * nb, WinT, D, 256 * nb, 64 * kb, scr, F.lane, seg);
        else transpose_item(F.w_in, NPROJ, 5120 + 64 * nb, WinT, D, 5120 + 64 * nb, 64 * kb, scr, F.lane);
        return; }
    it -= 1280;
    if (it < 256) { const int kb = it >> 4, nb = it & 15; transpose_item(F.w_out_conv, D, 64 * nb, (bf16*)(F.ws + WS_WOC), D, 64 * nb, 64 * kb, scr, F.lane); return; }
    it -= 256;
    if (it < 256) { const int kb = it >> 4, nb = it & 15; transpose_item(F.w_o, D, 64 * nb, (bf16*)(F.ws + WS_WO), D, 64 * nb, 64 * kb, scr, F.lane); return; }
}
constexpr int NCONV = 32;
struct XItem { const float* src; unsigned char* dst; int ld, K, r1; };
__device__ __forceinline__ XItem expert_item(Frame& F, int j) {
    XItem x; const int half = (j >> 11) & 1; int p = ((j >> 12) << 11) | (j & 2047);
    if (p < 8192) { const int up = p >= 4096 ? 1 : 0; p &= 4095; const int e = p >> 6, r = p & 63, kb = 2 * (r >> 3) + half, nb = r & 7;
        x.ld = DE; x.K = D; x.src = (up ? F.w_up : F.w_gate) + (size_t)e * D * DE + (size_t)(64 * kb) * DE + 64 * nb;
        x.r1 = 32; x.dst = (F.ws + WS_WGU) + (size_t)e * D * D + (size_t)(256 * (nb >> 1) + 128 * up + 64 * (nb & 1)) * D + 128 * (r >> 3); return x; }
    p -= 8192;
    { const int e = p >> 6, r = p & 63, kb = 2 * (r >> 4) + half, nb = r & 15;
        x.ld = D; x.K = DE; x.src = F.w_down + (size_t)e * DE * D + (size_t)(64 * kb) * D + 64 * nb;
        x.r1 = 128; x.dst = (F.ws + WS_WD) + (size_t)e * D * DE + (size_t)(256 * (nb >> 2) + 32 * (nb & 3)) * DE + 128 * (r >> 4); return x; }
}
__device__ __forceinline__ void xitem_load(const XItem& x, float (&tv)[64], int lane) {
    const float* wsrc = x.src + lane;
#pragma unroll
    for (int i = 0; i < 64; ++i) tv[i] = __builtin_nontemporal_load(wsrc + (size_t)i * x.ld);
}
__device__ __forceinline__ void xitem_pack(const float (&tv)[64], LAS float* scr, int lane, v2u (&o)[8]) {
#pragma unroll
    for (int i = 0; i < 64; ++i) scr[i * 65 + lane] = tv[i];
    LDS_WAIT(); asm volatile("" ::: "memory");
    const int c = lane & 7, nn = lane >> 3;
#pragma unroll
    for (int j = 0; j < 8; ++j) { const int n = nn + 8 * j; const LAS float* sp = scr + (8 * c) * 65 + n;
        const float ws_ = pg8::W8_SCALE;
        o[j] = (v2u){pg8::pk4_fp8(sp[0 * 65] * ws_, sp[1 * 65] * ws_, sp[2 * 65] * ws_, sp[3 * 65] * ws_), pg8::pk4_fp8(sp[4 * 65] * ws_, sp[5 * 65] * ws_, sp[6 * 65] * ws_, sp[7 * 65] * ws_)}; }
    LDS_WAIT(); asm volatile("" ::: "memory");
}
__device__ __forceinline__ void xpair_store(const XItem& x, const v2u (&oa)[8], const v2u (&ob)[8], int lane) {
    const int c = lane & 7, nn = lane >> 3; const bool odd = (c & 1) != 0;
#pragma unroll
    for (int j = 0; j < 8; ++j) { const int n = nn + 8 * j; const v2u snd = odd ? oa[j] : ob[j]; v2u rcv; rcv.x = __shfl_xor(snd.x, 1); rcv.y = __shfl_xor(snd.y, 1);
        const v4u w = odd ? (v4u){rcv.x, rcv.y, ob[j].x, ob[j].y} : (v4u){oa[j].x, oa[j].y, rcv.x, rcv.y};
        __builtin_nontemporal_store(w, (GAS v4u*)(x.dst + (size_t)((n & 31) + (n >> 5) * x.r1) * x.K + (odd ? 64 + 8 * (c - 1) : 8 * c))); }
}
__device__ __forceinline__ void convert_experts(Frame& F, int rank, int nranks) {
    LAS float* scr = (LAS float*)(F.lds + F.wave * 16640);
    const int st = nranks * NWAVES; int it = rank * NWAVES + F.wave;
    if (it >= 3 * 8192) return;
    float ta[64], tb[64]; v2u oa[8], ob[8]; XItem xa = expert_item(F, it), xb = xa;
    xitem_load(xa, ta, F.lane);
    for (;;) {
        xb = expert_item(F, it + st); xitem_load(xb, tb, F.lane);
        xitem_pack(ta, scr, F.lane, oa);
        const XItem xs = xa;
        it += 2 * st; const bool ha = it < 3 * 8192;
        if (ha) { xa = expert_item(F, it); xitem_load(xa, ta, F.lane); }
        xitem_pack(tb, scr, F.lane, ob);
        xpair_store(xs, oa, ob, F.lane);
        if (!ha) break;
    }
}
__device__ __forceinline__ void p0b_fold(Frame& F, int it, LAS float* scr) {
    const int g = it >> 9, r = it & 511, k0 = (r >> 2) * 8, e = (r & 3) * 64 + F.lane;
    float acc[8];
#pragma unroll
    for (int kk = 0; kk < 8; ++kk) acc[kk] = 0.f;
    const float* wp = F.w_pool + (size_t)g * 65536 + e;
    const float* wi = F.w_in + (size_t)k0 * NPROJ + 3072 + g * 256;
#pragma unroll
    for (int kk = 0; kk < 8; ++kk) ((LAS f32x4*)scr)[kk * 64 + F.lane] = *(const f32x4*)(wi + (size_t)kk * NPROJ + 4 * F.lane);
    float p0[16], p1[16];
#pragma unroll
    for (int j = 0; j < 16; ++j) p0[j] = wp[j * 256];
    LDS_WAIT(); asm volatile("" ::: "memory");
#define FOLD_STEP(PC, PN, S, MORE) { if (MORE) { _Pragma("unroll") for (int j = 0; j < 16; ++j) PN[j] = wp[(((S) + 1) * 16 + j) * 256]; } \
        _Pragma("unroll") for (int j = 0; j < 16; j += 4) { asm volatile("" ::: "memory"); \
            _Pragma("unroll") for (int kk = 0; kk < 8; ++kk) { const f32x4 w = *(const LAS f32x4*)(scr + kk * 256 + (S) * 16 + j); \
                acc[kk] += (w[0] * PC[j] + w[1] * PC[j + 1]) + (w[2] * PC[j + 2] + w[3] * PC[j + 3]); } } }
#pragma clang loop unroll(disable)
    for (int s8 = 0; s8 < 16; s8 += 2) {
        FOLD_STEP(p0, p1, s8, true)
        FOLD_STEP(p1, p0, s8 + 1, s8 + 2 < 16)
    }
#undef FOLD_STEP
    LDS_WAIT(); asm volatile("" ::: "memory");
    const float ps = F.pool_scale[g * 256 + e];
    v4u o0;
    o0.x = pk2(acc[0] * ps, acc[1] * ps); o0.y = pk2(acc[2] * ps, acc[3] * ps); o0.z = pk2(acc[4] * ps, acc[5] * ps); o0.w = pk2(acc[6] * ps, acc[7] * ps);
    bf16* dst = (bf16*)(F.ws + WS_WIN) + (size_t)(4096 + g * 256 + e) * D + k0;
    *(GAS v4u*)dst = o0;
}
__device__ __forceinline__ void p0b_rw(Frame& F, int it) {
    const int ks = it / 5, j = it - ks * 5, col = 16 * j + (F.lane & 15), kb = 32 * ks + 8 * (F.lane >> 4);
    float v[8];
#pragma unroll
    for (int e = 0; e < 8; ++e) { const int k = kb + e; const float* src = col < 8 ? F.w_group + k * 8 + col : F.w_router + k * 64 + (col < 72 ? col - 8 : 0); const float t = *src; v[e] = col < 72 ? t : 0.f; }
    unsigned hi[4], lo[4];
#pragma unroll
    for (int i = 0; i < 4; ++i) { const unsigned h0 = f2bf(v[2 * i]), h1 = f2bf(v[2 * i + 1]); hi[i] = h0 | (h1 << 16);
        lo[i] = pk2(v[2 * i] - __builtin_bit_cast(float, h0 << 16), v[2 * i + 1] - __builtin_bit_cast(float, h1 << 16)); }
    v4u* rw = (v4u*)(F.ws + WS_RW);
    rw[(size_t)(it * 2 + 0) * 64 + F.lane] = (v4u){hi[0], hi[1], hi[2], hi[3]};
    rw[(size_t)(it * 2 + 1) * 64 + F.lane] = (v4u){lo[0], lo[1], lo[2], lo[3]};
}
__device__ __forceinline__ void p0b_prologue(Frame& F) {
    const int gw = blockIdx.x * NWAVES + F.wave, NGW = F.G * NWAVES;
    const float* modp = (const float*)(F.ws + WS_MODP);
    LAS float* scr = (LAS float*)(F.lds + F.wave * 16640);
    for (int it = gw; it < 2048; it += NGW) p0b_fold(F, it, scr);
    for (int it = NGW - 1 - gw; it < 160; it += NGW) p0b_rw(F, it);
    for (int gid = gw * 64 + F.lane; gid < NBATCH * NPROJ; gid += NGW * 64) { const int b = gid / NPROJ, j = gid - b * NPROJ;
        float s = F.b_ada[j];
#pragma unroll
        for (int kc = 0; kc < NKC; ++kc) s += modp[((size_t)kc * 4 + b) * NPROJ + j];
        ((float*)(F.ws + WS_MOD))[gid] = s;
        if (gid < NBATCH * D) { const int bb = gid >> 10, cc = gid & 1023; float s2 = F.b_ada[4096 + cc], sh2 = F.b_ada[3072 + cc];
#pragma unroll
            for (int kc = 0; kc < NKC; ++kc) { s2 += modp[((size_t)kc * 4 + bb) * NPROJ + 4096 + cc]; sh2 += modp[((size_t)kc * 4 + bb) * NPROJ + 3072 + cc]; }
            float* gcbc = (float*)(F.ws + WS_GCBC); gcbc[gid] = F.ln1_g[cc] * (1.0f + s2); gcbc[NBATCH * D + gid] = F.ln1_b[cc] * (1.0f + s2) + sh2; } }
    for (int it = gw; it < NT_ITEMS; it += NGW) p0b_transpose(F, it, scr);
    bf16* U = (bf16*)(F.ws + WS_U);
    for (int blk = blockIdx.x; blk < NBLK; blk += F.G) { const int b = blk >> 6;
        LAS f32x4* ml = (LAS f32x4*)F.lds;
        __syncthreads();
        { const int c4 = 4 * F.tid; f32x4 pv[NKC], acc = *(const f32x4*)(F.b_ada + c4);
#pragma unroll
          for (int kc = 0; kc < NKC; ++kc) pv[kc] = *(const f32x4*)(modp + ((size_t)kc * 4 + b) * NPROJ + c4);
#pragma unroll
          for (int kc = 0; kc < NKC; ++kc) acc += pv[kc];
          ml[F.tid] = F.tid >= 256 ? acc + 1.0f : acc; }
        __syncthreads();
        f32x4 s1[4], sh1[4];
#pragma unroll
        for (int j = 0; j < 4; ++j) { sh1[j] = ml[F.lane + 64 * j]; s1[j] = ml[256 + F.lane + 64 * j]; }
        for (int rr = 0; rr < 16; rr += 4) { const size_t row = (size_t)blk * 128 + F.wave * 16 + rr;
            const GAS f32x4* xr = (const GAS f32x4*)(F.x + row * D) + F.lane; GAS v2u* ur = (GAS v2u*)(U + row * D) + F.lane;
            f32x4 xv[4][4];
#pragma unroll
            for (int q = 0; q < 4; ++q)
#pragma unroll
                for (int j = 0; j < 4; ++j) xv[q][j] = __builtin_nontemporal_load(xr + q * 256 + 64 * j);
#pragma unroll
            for (int q = 0; q < 4; ++q)
#pragma unroll
                for (int j = 0; j < 4; ++j) { const f32x4 v = xv[q][j] * s1[j] + sh1[j]; ur[q * 256 + 64 * j] = (v2u){pk2(v[0], v[1]), pk2(v[2], v[3])}; } }
    }
}

__device__ __forceinline__ void unpack8(const v4u w, float (&f)[8]) { f[0] = bflo(w.x); f[1] = bfhi(w.x); f[2] = bflo(w.y); f[3] = bfhi(w.y); f[4] = bflo(w.z); f[5] = bfhi(w.z); f[6] = bflo(w.w); f[7] = bfhi(w.w); }
__device__ __forceinline__ v4u pack8f(const float (&f)[8]) { return (v4u){pk2(f[0], f[1]), pk2(f[2], f[3]), pk2(f[4], f[5]), pk2(f[6], f[7])}; }
__device__ __forceinline__ void conv_fixup(Frame& F, int pm) {
    bf16* A2 = (bf16*)F.out;
    const bf16* VH = (const bf16*)(F.ws + WS_RAW); const bf16* ABH = VH + 128 * 2 * 1024; const bf16* VT = VH + 2 * 128 * 2 * 1024;
    const int r = F.tid >> 8, ch0 = (F.tid & 255) * 4;
    const v2u vh0 = *(const GAS v2u*)(VH + (size_t)(pm * 2 + 0) * 1024 + ch0), vh1 = *(const GAS v2u*)(VH + (size_t)(pm * 2 + 1) * 1024 + ch0), ab = *(const GAS v2u*)(ABH + (size_t)(pm * 2 + r) * 1024 + ch0);
    v2u t0 = (v2u){0u, 0u}, t1 = (v2u){0u, 0u};
    if (((pm * 256) & (T - 1)) > 0) { t0 = *(const GAS v2u*)(VT + (size_t)((pm - 1) * 2 + 0) * 1024 + ch0); t1 = *(const GAS v2u*)(VT + (size_t)((pm - 1) * 2 + 1) * 1024 + ch0); }
    const f32x4 w0 = *(const f32x4*)(F.conv_w + ch0), w1 = *(const f32x4*)(F.conv_w + 1024 + ch0), w2 = *(const f32x4*)(F.conv_w + 2048 + ch0);
    const f32x4 V0 = (f32x4){bflo(vh0.x), bfhi(vh0.x), bflo(vh0.y), bfhi(vh0.y)}, V1 = (f32x4){bflo(vh1.x), bfhi(vh1.x), bflo(vh1.y), bfhi(vh1.y)};
    const f32x4 T0 = (f32x4){bflo(t0.x), bfhi(t0.x), bflo(t0.y), bfhi(t0.y)}, T1 = (f32x4){bflo(t1.x), bfhi(t1.x), bflo(t1.y), bfhi(t1.y)}, AB = (f32x4){bflo(ab.x), bfhi(ab.x), bflo(ab.y), bfhi(ab.y)};
    const f32x4 o = (r == 0 ? (w0 * T0 + w1 * T1 + w2 * V0) : (w0 * T1 + w1 * V0 + w2 * V1)) * AB;
    *(GAS v2u*)(A2 + (size_t)(pm * 256 + r) * D + ch0) = (v2u){pk2(o[0], o[1]), pk2(o[2], o[3])};
}

__device__ __forceinline__ void p4_route(Frame& F) {
    const float* z = F.out; const f32x2* statp = (const f32x2*)(F.ws + WS_STATP);
    const float* gcbc = (const float*)(F.ws + WS_GCBC); const v4u* rw = (const v4u*)(F.ws + WS_RW);
    unsigned char* H = F.ws + WS_H; int* wgcnt = (int*)(F.ws + WS_WGCNT); v4u* tokinfo = (v4u*)(F.ws + WS_TOKINFO);
    LAS int* hist = (LAS int*)(F.lds + LT_HIST);
    LAS float* lg = (LAS float*)(F.lds + F.wave * 5120);
    const int r = F.lane & 15, q = F.lane >> 4;
    for (int blk = blockIdx.x; blk < NBLK; blk += F.G) {
        if (F.tid < 64) hist[F.tid] = 0;
        __syncthreads();
        const int row = blk * 128 + F.wave * 16 + r, b = blk >> 6;
        float s = 0.f, qq = 0.f;
#pragma unroll
        for (int i = 0; i < 4; ++i) { const f32x2 p = statp[(size_t)row * 16 + q * 4 + i]; s += p.x; qq += p.y; }
        s += __shfl_xor(s, 16); s += __shfl_xor(s, 32); qq += __shfl_xor(qq, 16); qq += __shfl_xor(qq, 32);
        const float mean = s * (1.0f / D), rstd = 1.0f / sqrtf(qq * (1.0f / D) - mean * mean + LN_EPS);
        pg8::f32x4 acc[5];
#pragma unroll
        for (int j = 0; j < 5; ++j) acc[j] = (pg8::f32x4){0.f, 0.f, 0.f, 0.f};
        const float* zr = z + (size_t)(blk * 128 + F.wave * 16 + (r & 7)) * D + 8 * q + 4 * (r >> 3);
        LAS unsigned char* hst = F.lds + F.wave * 5120;
        LAS float* gcl = (LAS float*)(F.lds + 73728); LAS float* bcl = gcl + D;
        LAS unsigned char* bb = F.lds + 49152;
        for (int i = F.tid; i < D / 4; i += 512) { ((LAS f32x4*)gcl)[i] = ((const f32x4*)(gcbc + b * D))[i]; ((LAS f32x4*)bcl)[i] = ((const f32x4*)(gcbc + NBATCH * D + b * D))[i]; }
        const v4u* rwl = rw + F.wave * 64 + F.lane;
        v4u br[4][2]; f32x4 zq[4][2];
#pragma unroll
        for (int k = 0; k < 4; ++k) { br[k][0] = rwl[(size_t)k * 640]; br[k][1] = F.wave < 2 ? rwl[(size_t)k * 640 + 512] : (v4u){0u, 0u, 0u, 0u}; }
#pragma unroll
        for (int k = 0; k < 4; ++k) { zq[k][0] = __builtin_nontemporal_load((const f32x4*)(zr + 32 * k)); zq[k][1] = __builtin_nontemporal_load((const f32x4*)(zr + 8 * D + 32 * k)); }
        { LAS v4u* d0 = (LAS v4u*)bb + F.wave * 64 + F.lane; d0[0] = br[0][0]; if (F.wave < 2) d0[512] = br[0][1]; }
        __syncthreads();
        for (int ks0 = 0; ks0 < 32; ks0 += 4)
#pragma unroll
        for (int u = 0; u < 4; ++u) { const int ks = ks0 + u;
            f32x4 z0, z1;
#pragma unroll
            for (int e = 0; e < 4; ++e) { z0[e] = pg8::dpp_fill<0x118>(zq[u][0][e], zq[u][1][e]); z1[e] = pg8::dpp_fill<0x108>(zq[u][1][e], zq[u][0][e]); }
            if (ks + 4 < 32) { zq[u][0] = __builtin_nontemporal_load((const f32x4*)(zr + 32 * (ks + 4))); zq[u][1] = __builtin_nontemporal_load((const f32x4*)(zr + 8 * D + 32 * (ks + 4))); }
            const f32x4 g0 = *(const LAS f32x4*)(gcl + 32 * ks + 8 * q), g1 = *(const LAS f32x4*)(gcl + 32 * ks + 8 * q + 4), b0 = *(const LAS f32x4*)(bcl + 32 * ks + 8 * q), b1 = *(const LAS f32x4*)(bcl + 32 * ks + 8 * q + 4);
            const f32x4 h0 = (z0 - mean) * rstd * g0 + b0, h1 = (z1 - mean) * rstd * g1 + b1;
            const float hv[8] = {h0[0], h0[1], h0[2], h0[3], h1[0], h1[1], h1[2], h1[3]};
            unsigned hi[4], lo[4];
#pragma unroll
            for (int i = 0; i < 4; ++i) { const unsigned a0 = f2bf(hv[2 * i]), a1 = f2bf(hv[2 * i + 1]); hi[i] = a0 | (a1 << 16);
                lo[i] = pk2(hv[2 * i] - __builtin_bit_cast(float, a0 << 16), hv[2 * i + 1] - __builtin_bit_cast(float, a1 << 16)); }
            const v4u hiv = (v4u){hi[0], hi[1], hi[2], hi[3]}, lov = (v4u){lo[0], lo[1], lo[2], lo[3]};
            *(LAS v2u*)(hst + r * 144 + u * 32 + q * 8) = (v2u){pg8::pk4_fp8(hv[0], hv[1], hv[2], hv[3]), pg8::pk4_fp8(hv[4], hv[5], hv[6], hv[7])};
            if (u == 3) {
#pragma unroll
                for (int j = 0; j < 2; ++j) { const int rw_ = 8 * j + (F.lane >> 3), c16 = F.lane & 7;
                    const v4u t = *(const LAS v4u*)(hst + rw_ * 144 + c16 * 16);
                    *(GAS v4u*)(H + (size_t)(blk * 128 + F.wave * 16 + rw_) * D + 32 * (ks - 3) + c16 * 16) = t; } }
            const pg8::bf16x8 Ah = __builtin_bit_cast(pg8::bf16x8, hiv), Al = __builtin_bit_cast(pg8::bf16x8, lov);
            const LAS v4u* bl = (const LAS v4u*)(bb + (ks & 1) * 10240) + F.lane;
#pragma unroll
            for (int j = 0; j < 5; ++j) { const pg8::bf16x8 Bh = __builtin_bit_cast(pg8::bf16x8, bl[(j * 2 + 0) * 64]), Bl = __builtin_bit_cast(pg8::bf16x8, bl[(j * 2 + 1) * 64]);
                acc[j] = __builtin_amdgcn_mfma_f32_16x16x32_bf16(Ah, Bh, acc[j], 0, 0, 0);
                acc[j] = __builtin_amdgcn_mfma_f32_16x16x32_bf16(Al, Bh, acc[j], 0, 0, 0);
                acc[j] = __builtin_amdgcn_mfma_f32_16x16x32_bf16(Ah, Bl, acc[j], 0, 0, 0); }
            if (ks + 1 < 32) { LAS v4u* d1 = (LAS v4u*)(bb + ((ks + 1) & 1) * 10240) + F.wave * 64 + F.lane; d1[0] = br[(u + 1) & 3][0]; if (F.wave < 2) d1[512] = br[(u + 1) & 3][1]; }
            if (ks + 4 < 32) { br[u][0] = rwl[(size_t)(ks + 4) * 640]; if (F.wave < 2) br[u][1] = rwl[(size_t)(ks + 4) * 640 + 512]; }
            __syncthreads();
        }
#pragma unroll
        for (int j = 0; j < 5; ++j)
#pragma unroll
            for (int g = 0; g < 4; ++g) lg[(4 * q + g) * 80 + 16 * j + r] = acc[j][g];
        __syncthreads();
        if (F.lane < 16) {
            const LAS float* L = lg + F.lane * 80; const int token = blk * 128 + F.wave * 16 + F.lane;
            float gl[8];
#pragma unroll
            for (int i = 0; i < 8; ++i) gl[i] = L[i] + F.b_group[i];
            int g = 0; float gm = gl[0];
#pragma unroll
            for (int i = 1; i < 8; ++i) if (gl[i] > gm) { gm = gl[i]; g = i; }
            float gs = 0.f;
#pragma unroll
            for (int i = 0; i < 8; ++i) gs += __expf(gl[i] - gm);
            const float gp = 1.0f / gs;
            float el[8];
#pragma unroll
            for (int i = 0; i < 8; ++i) el[i] = L[8 + g * 8 + i] + F.b_router[g * 8 + i];
            int e1 = 0; float m1 = el[0];
#pragma unroll
            for (int i = 1; i < 8; ++i) if (el[i] > m1) { m1 = el[i]; e1 = i; }
            int e2 = -1; float m2 = -3.0e38f;
#pragma unroll
            for (int i = 0; i < 8; ++i) if (i != e1 && el[i] > m2) { m2 = el[i]; e2 = i; }
            if (e2 < 0) e2 = (e1 + 1) & 7;
            const float p = __expf(m2 - m1), w1 = gp / (1.0f + p), w2 = gp * p / (1.0f + p);
            const int E1 = g * 8 + e1, E2 = g * 8 + e2;
            const int r1 = atomicAdd((int*)(F.ldsg + LT_HIST) + E1, 1), r2 = atomicAdd((int*)(F.ldsg + LT_HIST) + E2, 1);
            tokinfo[token] = (v4u){(unsigned)(E1 | (r1 << 8)), (unsigned)(E2 | (r2 << 8)), __builtin_bit_cast(unsigned, w1), __builtin_bit_cast(unsigned, w2)};
        }
        __syncthreads();
        if (F.tid < 64) wgcnt[blk * 64 + F.tid] = hist[F.tid];
        __syncthreads();
    }
}

__device__ __forceinline__ void p5a_dispatch(Frame& F, bool copy) {
    const int* wgcnt = (const int*)(F.ws + WS_WGCNT); const v4u* tokinfo = (const v4u*)(F.ws + WS_TOKINFO);
    int* row_slot = (int*)(F.ws + WS_ROWSLOT); float* row_wt = (float*)(F.ws + WS_ROWWT);
    int* row_tok = (int*)(F.ws + WS_ROWTOK);
    LAS int* pad_start = (LAS int*)(F.lds + LT_PADSTART); LAS int* tile_e = (LAS int*)(F.lds + LT_TILEE);
    LAS int* tot = (LAS int*)(F.lds + LT_TOT); LAS int* base = (LAS int*)(F.lds + LT_BASE);
    LAS int* ae = (LAS int*)(F.lds + LT_AE); LAS int* psum = (LAS int*)(F.lds + LT_PSUM);
    const int e_ = F.tid & 63, part = F.tid >> 6;
    bool first = true;
    for (int blk = blockIdx.x; blk < NBLK || first; blk += F.G) {
        int sa = 0, sb = 0;
#pragma unroll
        for (int i = 0; i < 32; ++i) { const int wg = part * 32 + i; const int v = wgcnt[wg * 64 + e_]; sa += v; sb += wg < blk ? v : 0; }
        psum[part * 64 + e_] = sa; psum[512 + part * 64 + e_] = sb;
        __syncthreads();
        if (F.tid < 64) { int a = 0, bsum = 0;
#pragma unroll
            for (int p = 0; p < 8; ++p) { a += psum[p * 64 + F.tid]; bsum += psum[512 + p * 64 + F.tid]; }
            tot[F.tid] = a; base[F.tid] = bsum; }
        __syncthreads();
        if (first) {
            if (F.tid < 64) { const int cnt = tot[F.tid], nt_ = (cnt + 255) >> 8, sm = ((cnt & 255) != 0 && (cnt & 255) <= 128) ? 1 : 0;
                int incl = nt_, inf = nt_ - sm, ins = sm;
#pragma unroll
                for (int o = 1; o < 64; o <<= 1) { const int v = __shfl_up(incl, o), vf = __shfl_up(inf, o), vs = __shfl_up(ins, o); if (F.tid >= o) { incl += v; inf += vf; ins += vs; } }
                const int nfull = __shfl(inf, 63), st = incl - nt_; pad_start[F.tid] = st << 8;
                for (int k = 0; k < nt_ - sm; ++k) tile_e[inf - (nt_ - sm) + k] = (st + k) | (F.tid << 16);
                if (sm) tile_e[nfull + ins - 1] = (st + nt_ - 1) | (F.tid << 16);
                if (F.tid == 63) { pad_start[64] = incl << 8; pad_start[65] = incl; pad_start[66] = nfull; } }
            __syncthreads();
            if (!copy) return;
            for (int e = blockIdx.x; e < NE; e += F.G) { const int p0 = pad_start[e] + tot[e], p1 = pad_start[e + 1]; for (int p = p0 + F.tid; p < p1; p += 512) { row_slot[p] = -1; row_wt[p] = 0.f; row_tok[p] = 0; } }
            first = false;
        }
        if (blk < NBLK) {
            if (F.tid < 256) { const int token = blk * 128 + (F.tid >> 1), k = F.tid & 1; const v4u info = tokinfo[token]; const unsigned ek = k ? info.y : info.x;
                const int e = (int)(ek & 255u), rank = (int)(ek >> 8); const float wt = __builtin_bit_cast(float, k ? info.w : info.z);
                const int pos = pad_start[e] + base[e] + rank; row_slot[pos] = token * 2 + k; row_wt[pos] = wt; row_tok[pos] = token; }
            __syncthreads();

        }
        __syncthreads();
    }
}

constexpr int P7R = 4;
__device__ __forceinline__ void p7_final(Frame& F) {
    float* z = F.out; const f32x2* statp = (const f32x2*)(F.ws + WS_STATP); const bf16* O = (const bf16*)(F.ws + WS_O); const float* mod = (const float*)(F.ws + WS_MOD);
    { int t_ = threadIdx.x; asm volatile("" : "+v"(t_)); F.tid = t_; F.lane = t_ & 63; }
    { const int blk = blockIdx.x, b = blk >> 6;
        f32x4 g1[4], b1[4], gt[4];
#pragma unroll
        for (int j = 0; j < 4; ++j) { const int col = 4 * F.lane + 256 * j; g1[j] = *(const f32x4*)(F.ln1_g + col); b1[j] = *(const f32x4*)(F.ln1_b + col); gt[j] = *(const f32x4*)(mod + b * NPROJ + 5 * D + col) + 1.0f; }
        LAS f32x4* l2 = (LAS f32x4*)F.lds;
        __syncthreads();
        l2[F.tid] = F.tid < 256 ? ((const f32x4*)F.ln2_g)[F.tid] : ((const f32x4*)F.ln2_b)[F.tid - 256];
        __syncthreads();
        for (int rr = 0; rr < 16; rr += P7R) { const size_t row0 = (size_t)blk * 128 + F.wave * 16 + rr;
            f32x4 zv[P7R][4]; v2u oa[P7R][4], oc[P7R][4]; f32x2 p[P7R];
#pragma unroll
            for (int u = 0; u < P7R; ++u) { const size_t row = row0 + u;
                p[u] = (f32x2){0.f, 0.f}; if (F.lane < 16) p[u] = statp[row * 16 + F.lane];
                const GAS f32x4* zr = (const GAS f32x4*)(z + row * D) + F.lane;
                const GAS v2u* o1 = (const GAS v2u*)(O + (2 * row) * D) + F.lane; const GAS v2u* o2 = (const GAS v2u*)(O + (2 * row + 1) * D) + F.lane;
#pragma unroll
                for (int j = 0; j < 4; ++j) { zv[u][j] = __builtin_nontemporal_load(zr + 64 * j); oa[u][j] = __builtin_nontemporal_load(o1 + 64 * j); oc[u][j] = __builtin_nontemporal_load(o2 + 64 * j); } }
            float s[P7R];
#pragma unroll
            for (int u = 0; u < P7R; ++u) {
                const float mean = wave_sum(p[u].x) * (1.0f / D), rstd = 1.0f / sqrtf(wave_sum(p[u].y) * (1.0f / D) - mean * mean + LN_EPS);
                s[u] = 0.f;
#pragma unroll
                for (int j = 0; j < 4; ++j) { const v2u a = oa[u][j], c = oc[u][j];
                    const f32x4 y = (f32x4){bflo(a.x) + bflo(c.x), bfhi(a.x) + bfhi(c.x), bflo(a.y) + bflo(c.y), bfhi(a.y) + bfhi(c.y)};
                    const f32x4 x1 = (zv[u][j] - mean) * rstd * g1[j] + b1[j];
                    zv[u][j] = x1 * ALPHA + gt[j] * y; s[u] += (zv[u][j][0] + zv[u][j][1]) + (zv[u][j][2] + zv[u][j][3]); } }
#pragma unroll
            for (int u = 0; u < P7R; ++u) { const size_t row = row0 + u;
                const float mean2 = wave_sum(s[u]) * (1.0f / D); float s2 = 0.f;
#pragma unroll
                for (int j = 0; j < 4; ++j) { zv[u][j] = zv[u][j] - mean2; s2 += (zv[u][j][0] * zv[u][j][0] + zv[u][j][1] * zv[u][j][1]) + (zv[u][j][2] * zv[u][j][2] + zv[u][j][3] * zv[u][j][3]); }
                const float rstd2 = 1.0f / sqrtf(wave_sum(s2) * (1.0f / D) + LN_EPS);
                GAS f32x4* zw = (GAS f32x4*)(z + row * D) + F.lane;
#pragma unroll
                for (int j = 0; j < 4; ++j) __builtin_nontemporal_store(zv[u][j] * rstd2 * l2[F.lane + 64 * j] + l2[256 + F.lane + 64 * j], zw + 64 * j); }
        }
    }
}

__device__ __forceinline__ void fill_rs(Frame& F, int t, int vcu, int ntiles) {
    const int* row_slot = (const int*)(F.ws + WS_ROWSLOT); const float* row_wt = (const float*)(F.ws + WS_ROWWT); LAS v2u* rs = (LAS v2u*)(F.lds + LT_HIST);
    int sl[5]; float wv[5];
#pragma unroll
    for (int i = 0; i < 5; ++i) { const int L = i * F.G + vcu; const bool ok = L < ntiles * 4; const int row = (ok ? (((const LAS int*)(F.lds + LT_TILEE))[L >> 2] & 0xffff) : 0) * 256 + t; sl[i] = ok ? row_slot[row] : -1; wv[i] = ok ? row_wt[row] : 0.f; }
#pragma unroll
    for (int i = 0; i < 5; ++i) rs[i * 256 + t] = (v2u){(unsigned)sl[i], __builtin_bit_cast(unsigned, wv[i])};
}

struct Args { const float* in[21]; float* out; unsigned char* ws; int ph_lo, ph_hi; };
#ifndef MK_N_LAUNCHES
#define MK_N_LAUNCHES 1
#endif
constexpr int N_PHASES = 11;
static_assert(NBLK == 256, "P7 takes one row block per workgroup of the 256-workgroup grid");
#ifndef KNOB_ALIGN
#define KNOB_ALIGN true
#endif
__global__ void __launch_bounds__(NWAVES * 64, 2) fwd(Args args) {
    extern __shared__ __attribute__((aligned(16))) unsigned char lds[];
    Frame F;
    F.lds = (LAS unsigned char*)lds; F.ldsg = lds;
    F.tid = threadIdx.x; F.lane = F.tid & 63; F.wave = __builtin_amdgcn_readfirstlane(F.tid >> 6); F.G = gridDim.x;
    F.ws = args.ws; F.out = args.out; F.ctl = (gu32*)(args.ws + WS_CTL);
    F.x = args.in[0]; F.c = args.in[1]; F.w_ada = args.in[2]; F.b_ada = args.in[3]; F.w_in = args.in[4]; F.conv_w = args.in[5]; F.w_out_conv = args.in[6]; F.w_pool = args.in[7];
    F.pool_scale = args.in[8]; F.w_o = args.in[9]; F.ln1_g = args.in[10]; F.ln1_b = args.in[11]; F.w_group = args.in[12]; F.b_group = args.in[13]; F.w_router = args.in[14];
    F.b_router = args.in[15]; F.w_gate = args.in[16]; F.w_up = args.in[17]; F.w_down = args.in[18]; F.ln2_g = args.in[19]; F.ln2_b = args.in[20];
    for (int u = F.tid; u < (LDS_BYTES - MISC_OFF) / 4; u += NWAVES * 64) ((LAS unsigned*)(F.lds + MISC_OFF))[u] = 0u;
    __syncthreads();
    XcdBarrier bar; bar.bar = (unsigned*)(F.ctl + CW_BAR); bar.x = 0; bar.st = nullptr;
    if (args.ph_hi - args.ph_lo > 1) bar = xcd_barrier_post((unsigned*)(F.ctl + CW_BAR), (volatile LAS unsigned*)(F.lds + MISC_OFF) + 8);
    const int bx = blockIdx.x, vcu = (F.G % 8 == 0) ? (bx % 8) * (F.G / 8) + bx / 8 : bx;

    const int lo = args.ph_lo, hi = args.ph_hi;
#define IN(k) (lo <= (k) && (k) < hi)
#define SEAM(k) do { if (IN(k) && IN((k) + 1)) xcd_barrier(bar); } while (0)
    if (IN(0)) p0a_mod(F);
    SEAM(0);
    if (IN(1)) { for (int i = F.tid; i < 3 * 1024 / 4; i += 512) ((LAS f32x4*)(F.lds + LT_CONVW))[i] = ((const f32x4*)F.conv_w)[i];
      p0b_prologue(F); }
    SEAM(1);
    if (IN(2)) { pg8::Gemm g{(const bf16*)(F.ws + WS_U), (const bf16*)(F.ws + WS_WIN), M, NPROJ, D}; pg8::StaticOrder S; S.init(M, NPROJ, F.G, bx);
      pg8::EpiProj E{(bf16*)F.out, F.ws + WS_GA, (bf16*)(F.ws + WS_Q), F.ws + WS_GB, (bf16*)(F.ws + WS_RAW), (bf16*)(F.ws + WS_RAW) + 128 * 2 * 1024, (bf16*)(F.ws + WS_RAW) + 2 * 128 * 2 * 1024, (const LAS float*)(F.lds + LT_CONVW), (LAS float*)(F.lds + RING_BYTES)};
      if (!IN(1)) { for (int i = F.tid; i < 3 * 1024 / 4; i += 512) ((LAS f32x4*)(F.lds + LT_CONVW))[i] = ((const f32x4*)F.conv_w)[i]; }
      __syncthreads();
      const bool first = ((bx >> 3) & 1) != 0;
      if (first) { convert_experts(F, blockIdx.x, F.G); __syncthreads(); }
      pg8::gemm_phase<pg8::EpiProj, pg8::StaticOrder, KNOB_ALIGN, true>(F.lds + RING_OFF, g, S, E);
      if (!first) { __syncthreads(); convert_experts(F, blockIdx.x, F.G); } }
    SEAM(2);
    if (IN(4)) { pg8::Gemm g{(const bf16*)F.out, (const bf16*)(F.ws + WS_WOC), M, D, D};
      pg8::StaticOrder S; S.init(M, D, F.G, bx);
      pg8::EpiMerge E{F.ws + WS_GA, F.ws + WS_GB, (const bf16*)(F.ws + WS_Q), (bf16*)(F.ws + WS_MG)};
      { pg8::Unit uu; for (int i = 0; S.next(i, uu); ++i) conv_fixup(F, uu.pm);
        VM_WAIT(); __syncthreads(); }
      pg8::gemm_phase<pg8::EpiMerge, pg8::StaticOrder, KNOB_ALIGN, true>(F.lds + RING_OFF, g, S, E); }
    SEAM(4);
    if (IN(5)) { pg8::Gemm g{(const bf16*)(F.ws + WS_MG), (const bf16*)(F.ws + WS_WO), M, D, D}; pg8::StaticOrder S; S.init(M, D, F.G, bx);
      pg8::EpiZ E{F.x, F.out, (const float*)(F.ws + WS_MOD), (pg8::f32x2*)(F.ws + WS_STATP), ALPHA};
      pg8::gemm_phase<pg8::EpiZ, pg8::StaticOrder, KNOB_ALIGN, true>(F.lds + RING_OFF, g, S, E); }
    SEAM(5);
    if (IN(6)) p4_route(F);
    SEAM(6);
    if (IN(7)) p5a_dispatch(F, true);
    SEAM(7);
    if (IN(8)) { if (!IN(7)) p5a_dispatch(F, false);
      const int ntiles = ((LAS int*)(F.lds + LT_PADSTART))[65];
      pg8::Gemm g{(const bf16*)(F.ws + WS_H), (const bf16*)(F.ws + WS_WGU), CAP, 4 * 256, D / 2};
      pg8::MoeOrder S{F.G, vcu, ntiles * 4, ((LAS int*)(F.lds + LT_PADSTART))[66], (const LAS int*)(F.lds + LT_TILEE)};
      pg8::EpiGU E{F.ws + WS_ACT};
      LAS unsigned short* toks = (LAS unsigned short*)(F.lds + RING_BYTES);
      { const int* row_tok = (const int*)(F.ws + WS_ROWTOK);
        if (F.tid < 256) { int tk[5];
#pragma unroll
          for (int i = 0; i < 5; ++i) { const int L = i * F.G + vcu; tk[i] = L < ntiles * 4 ? row_tok[(((const LAS int*)(F.lds + LT_TILEE))[L >> 2] & 0xffff) * 256 + F.tid] : 0; }
#pragma unroll
          for (int i = 0; i < 5; ++i) toks[i * 256 + F.tid] = (unsigned short)tk[i]; }
        else fill_rs(F, F.tid - 256, vcu, ntiles);
        __syncthreads(); }
      pg8::gemm_phase<pg8::EpiGU, pg8::MoeOrder, KNOB_ALIGN, true, true, pg8::NoPost, true>(F.lds + RING_OFF, g, S, E, toks); }
    SEAM(8);
    if (IN(9)) { if (!IN(7)) p5a_dispatch(F, false);
      const int ntiles = ((LAS int*)(F.lds + LT_PADSTART))[65];
      pg8::Gemm g{(const bf16*)(F.ws + WS_ACT), (const bf16*)(F.ws + WS_WD), CAP, 4 * 256, DE / 2};
      pg8::MoeOrder S{F.G, vcu, ntiles * 4, ((LAS int*)(F.lds + LT_PADSTART))[66], (const LAS int*)(F.lds + LT_TILEE)};
      LAS v2u* rs = (LAS v2u*)(F.lds + LT_HIST);
      if (!IN(8) || !IN(7)) { if (F.tid < 256) fill_rs(F, F.tid, vcu, ntiles); __syncthreads(); }
      pg8::EpiDown E{(bf16*)(F.ws + WS_O), (const LAS pg8::u32x2*)rs};
      pg8::gemm_phase<pg8::EpiDown, pg8::MoeOrder, KNOB_ALIGN, true, false, pg8::NoPost, true>(F.lds + RING_OFF, g, S, E); }
    SEAM(9);
    if (IN(10)) p7_final(F);
#undef IN
#undef SEAM
}

extern "C" void kernel_launch(void* const* d_in, const int* in_sizes, int n_in, void* d_out, int out_size, void* d_ws, size_t ws_size, hipStream_t stream) {
    static int grid = 0;
    if (grid == 0) {
        if (n_in != 21 || in_sizes[0] != M * D || out_size != M * D || ws_size < WS_END) { fprintf(stderr, "kernel_launch: built for 21 inputs, x/out of %d floats, >= %zu bytes of workspace; got n_in %d, in0 %d, out %d, ws %zu; nothing launched\n", M * D, (size_t)WS_END, n_in, n_in > 0 ? in_sizes[0] : -1, out_size, ws_size); grid = -1; return; }
        int dev = 0, cus = 0, per_cu = 0;
        if (hipGetDevice(&dev) != hipSuccess || hipDeviceGetAttribute(&cus, hipDeviceAttributeMultiprocessorCount, dev) != hipSuccess) { fprintf(stderr, "kernel_launch: device query failed\n"); grid = -1; return; }
        if (hipFuncSetAttribute((const void*)fwd, hipFuncAttributeMaxDynamicSharedMemorySize, LDS_BYTES) != hipSuccess) { fprintf(stderr, "kernel_launch: hipFuncSetAttribute failed\n"); grid = -1; return; }
        if (hipOccupancyMaxActiveBlocksPerMultiprocessor(&per_cu, (const void*)fwd, NWAVES * 64, LDS_BYTES) != hipSuccess || per_cu < 1) fprintf(stderr, "kernel_launch: note: occupancy query reports %d workgroups per CU\n", per_cu);
        (void)hipGetLastError();
        if (cus < 256) { fprintf(stderr, "kernel_launch: built for 256 CUs (per-workgroup LDS tables hold <= 5 expert units), found %d\n", cus); grid = -1; return; }
        grid = 256;
    }
    if (grid < 0) return;
    if (hipMemsetAsync((char*)d_ws + WS_CTL, 0, CTL_ZERO_BYTES, stream) != hipSuccess) { fprintf(stderr, "kernel_launch: memset failed\n"); return; }
    Args a{};
    for (int i = 0; i < 21; ++i) a.in[i] = (const float*)d_in[i];
    a.out = (float*)d_out; a.ws = (unsigned char*)d_ws;
#if MK_N_LAUNCHES == 1
    a.ph_lo = 0; a.ph_hi = N_PHASES;
    hipLaunchKernelGGL(fwd, dim3(grid), dim3(NWAVES * 64), LDS_BYTES, stream, a);
#else
    for (int p = 0; p < N_PHASES; ++p) {
        a.ph_lo = p; a.ph_hi = p + 1; hipLaunchKernelGGL(fwd, dim3(grid), dim3(NWAVES * 64), LDS_BYTES, stream, a);
    }
#endif
    const hipError_t le = hipPeekAtLastError();
    if (le != hipSuccess) fprintf(stderr, "kernel_launch: launch failed: %s\n", hipGetErrorName(le));
}
```

```cpp
#define MK_N_LAUNCHES 1
#include <hip/hip_runtime.h>
#include <cstdio>
#include <cstdint>
namespace pg8 {
#define PG8_LAS __attribute__((address_space(3)))
typedef unsigned short bf16_t;
typedef short bf16x8 __attribute__((ext_vector_type(8)));
typedef float f32x4 __attribute__((ext_vector_type(4)));
typedef unsigned u32x4 __attribute__((ext_vector_type(4)));
constexpr int BM = 256, BK = 64, HALF = 128, HTB = HALF * BK * 2  , STAGE_BYTES = 8 * HTB, NXCD = 8, WGM = 8;

__host__ __device__ __forceinline__ int lds_byte(int r, int c) { const int st = (r >> 4) * 2 + (c >> 5), rr = r & 15, cc = c & 31, ob = rr * 64 + cc * 2; return st * 1024 + (ob ^ (((ob >> 9) & 1) << 5)); }
__host__ __device__ __forceinline__ void stage_rc(int b, int& R, int& C) { const int st = b / 1024, sb = b % 1024, swz = sb ^ (((sb >> 9) & 1) << 5); R = (st >> 1) * 16 + swz / 64; C = (st & 1) * 32 + (swz % 64) / 2; }
__host__ __device__ __forceinline__ int perm32(int rho) { const int n = rho >> 4, i = rho & 15; return 8 * (i >> 2) + 4 * n + (i & 3); }

struct Unit { int pm, pn, ord, hm; };
struct Gemm { const bf16_t* A; const bf16_t* Bt; int M, N, K; };

struct StaticOrder {
    int nM, nN, nwg, G, c;
    __host__ __device__ void init(int M, int N, int G_, int c_) { nM = M / BM; nN = N / BM; nwg = nM * nN; G = G_; c = c_; }
    __host__ __device__ bool next(int i, Unit& u) const {
        const long L = (long)i * G + c; if (L >= nwg) return false;
        int wgid = (int)L; { const int q = nwg / NXCD, r = nwg % NXCD, xcd = wgid % NXCD, off = wgid / NXCD; wgid = (xcd < r ? xcd * (q + 1) : r * (q + 1) + (xcd - r) * q) + off; }
        const int nig = WGM * nN, gid = wgid / nig, fm = gid * WGM, gsz = (nM - fm) < WGM ? (nM - fm) : WGM;
        u.pm = fm + ((wgid % nig) % gsz); u.pn = (wgid % nig) / gsz; u.ord = i; u.hm = 0; return true;
    }
    __device__ __forceinline__ void a_ready(const Unit&) const {}
    __device__ __forceinline__ void done(const Unit&) const {}
};
typedef __bf16 bf16v2_t __attribute__((ext_vector_type(2)));
typedef float f32x2 __attribute__((ext_vector_type(2)));
__device__ __forceinline__ unsigned cvt_pk_bf16(float lo, float hi) { const bf16v2_t r = __builtin_convertvector((f32x2){lo, hi}, bf16v2_t); return __builtin_bit_cast(unsigned, r); }

typedef unsigned u32x2 __attribute__((ext_vector_type(2)));
__device__ __forceinline__ float bf_lo(unsigned w) { return __builtin_bit_cast(float, w << 16); }
__device__ __forceinline__ float bf_hi(unsigned w) { return __builtin_bit_cast(float, w & 0xffff0000u); }
__device__ __forceinline__ float sigmoidf_(float x) { return __builtin_amdgcn_rcpf(1.0f + __expf(-x)); }
__device__ __forceinline__ u32x4 pack8(const f32x4 v0, const f32x4 v1) { u32x4 w; w.x = cvt_pk_bf16(v0[0], v0[1]); w.y = cvt_pk_bf16(v0[2], v0[3]); w.z = cvt_pk_bf16(v1[0], v1[1]); w.w = cvt_pk_bf16(v1[2], v1[3]); return w; }

__device__ __forceinline__ unsigned pk4_u8(float a, float b, float c, float d) { int r = 0; r = __builtin_amdgcn_cvt_pk_u8_f32(a * 255.0f, 0, r); r = __builtin_amdgcn_cvt_pk_u8_f32(b * 255.0f, 1, r); r = __builtin_amdgcn_cvt_pk_u8_f32(c * 255.0f, 2, r); r = __builtin_amdgcn_cvt_pk_u8_f32(d * 255.0f, 3, r); return (unsigned)r; }
__device__ __forceinline__ float u8f(unsigned w, int b) { return (float)((w >> (8 * b)) & 0xffu) * (1.0f / 255.0f); }
template <int CTRL> __device__ __forceinline__ float dpp_mov(float v) { return __builtin_bit_cast(float, __builtin_amdgcn_update_dpp(0, __builtin_bit_cast(int, v), CTRL, 0xF, 0xF, false)); }
template <int CTRL> __device__ __forceinline__ unsigned dpp_fillu(unsigned old, unsigned v) { return (unsigned)__builtin_amdgcn_update_dpp((int)old, (int)v, CTRL, 0xF, 0xF, false); }
template <int CTRL> __device__ __forceinline__ float dpp_fill(float old, float v) { return __builtin_bit_cast(float, __builtin_amdgcn_update_dpp(__builtin_bit_cast(int, old), __builtin_bit_cast(int, v), CTRL, 0xF, 0xF, false)); }
__device__ __forceinline__ size_t blk_index(int pm, int g, int wave, int ai, int bj, int m) { return (size_t)((((((pm * 4 + g) * 8 + wave) * 2 + ai) * 2 + bj) * 4 + m)); }
struct EpiProj {
    static constexpr bool PERM = true, AFTER_DRAIN = false;
    bf16_t *A2; unsigned char* GA; bf16_t* Q; unsigned char* GB; bf16_t *VH, *ABH, *VT; const PG8_LAS float* conv_w; PG8_LAS float* xb;
    __device__ __forceinline__ void operator()(const f32x4 (&acc)[2][2][4][2], const Unit& u, int wr, int wc, int fr, int fq) const {
        const int row0 = u.pm * BM + wr * 64 + fr, pn = u.pn;
        if (pn >= 16) {
            const int g = pn & 3, wave = wr * 4 + wc, lane8 = (fq * 16 + fr) * 8;
            if (pn < 20) {
#pragma unroll
                for (int ai = 0; ai < 2; ++ai)
#pragma unroll
                    for (int m = 0; m < 4; ++m)
#pragma unroll
                        for (int bj = 0; bj < 2; ++bj) *(u32x4*)(Q + blk_index(u.pm, g, wave, ai, bj, m) * 512 + lane8) = pack8(acc[ai][bj][m][0], acc[ai][bj][m][1]);
            } else {
#pragma unroll
                for (int ai = 0; ai < 2; ++ai)
#pragma unroll
                    for (int m = 0; m < 4; ++m)
#pragma unroll
                        for (int bj = 0; bj < 2; ++bj) { f32x4 v0 = acc[ai][bj][m][0], v1 = acc[ai][bj][m][1];
#pragma unroll
                            for (int j = 0; j < 4; ++j) { v0[j] = sigmoidf_(v0[j]); v1[j] = sigmoidf_(v1[j]); }
                            *(u32x2*)(GB + blk_index(u.pm, g, wave, ai, bj, m) * 512 + lane8) = (u32x2){pk4_u8(v0[0], v0[1], v0[2], v0[3]), pk4_u8(v1[0], v1[1], v1[2], v1[3])}; }
            }
            return;
        }
        const int ch0 = pn * 64 + wc * 16 + 4 * fq;
        const f32x4 w0 = *(const PG8_LAS f32x4*)(conv_w + ch0), w1 = *(const PG8_LAS f32x4*)(conv_w + 1024 + ch0), w2 = *(const PG8_LAS f32x4*)(conv_w + 2048 + ch0);
#pragma unroll
        for (int ai = 0; ai < 2; ++ai) { const f32x4 vt = acc[ai][0][3][0] * acc[ai][0][3][1];
            if (fr >= 14) { *(PG8_LAS f32x4*)(xb + ((wc * 4 + 2 * ai + wr) * 2 + (fr - 14)) * 16 + 4 * fq) = vt;
                if (ai == 1 && wr == 1) *(u32x2*)(VT + (size_t)(u.pm * 2 + (fr - 14)) * 1024 + ch0) = (u32x2){cvt_pk_bf16(vt[0], vt[1]), cvt_pk_bf16(vt[2], vt[3])}; } }
        asm volatile("s_waitcnt lgkmcnt(0)" ::: "memory"); __builtin_amdgcn_s_barrier(); asm volatile("" ::: "memory");
#pragma unroll
        for (int ai = 0; ai < 2; ++ai) { const int q = 2 * ai + wr;
            f32x4 t14 = (f32x4){0.f, 0.f, 0.f, 0.f}, t15 = t14, vprev = t14;
            if (q > 0) { t14 = *(const PG8_LAS f32x4*)(xb + ((wc * 4 + q - 1) * 2 + 0) * 16 + 4 * fq); t15 = *(const PG8_LAS f32x4*)(xb + ((wc * 4 + q - 1) * 2 + 1) * 16 + 4 * fq); }
            u32x2 a2w[4]; unsigned gaw[4];
#pragma unroll
            for (int m = 0; m < 4; ++m) { const f32x4 V = acc[ai][0][m][0] * acc[ai][0][m][1], ab = acc[ai][1][m][0]; f32x4 o, ga;
#pragma unroll
                for (int e = 0; e < 4; ++e) { float p1, p2;
                    if (m == 0) { p1 = t15[e]; p2 = fr == 1 ? t15[e] : t14[e]; } else { p1 = dpp_mov<0x10F>(vprev[e]); p2 = dpp_mov<0x10E>(vprev[e]); }
                    const float vm1 = dpp_fill<0x111>(p1, V[e]), vm2 = dpp_fill<0x112>(p2, V[e]);
                    o[e] = (w0[e] * vm2 + w1[e] * vm1 + w2[e] * V[e]) * ab[e]; ga[e] = sigmoidf_(acc[ai][1][m][1][e]); }
                if (q == 0 && m == 0 && fr < 2) { *(u32x2*)(VH + (size_t)(u.pm * 2 + fr) * 1024 + ch0) = (u32x2){cvt_pk_bf16(V[0], V[1]), cvt_pk_bf16(V[2], V[3])};
                    *(u32x2*)(ABH + (size_t)(u.pm * 2 + fr) * 1024 + ch0) = (u32x2){cvt_pk_bf16(ab[0], ab[1]), cvt_pk_bf16(ab[2], ab[3])}; }
                a2w[m] = (u32x2){cvt_pk_bf16(o[0], o[1]), cvt_pk_bf16(o[2], o[3])}; gaw[m] = pk4_u8(ga[0], ga[1], ga[2], ga[3]);
                vprev = V; }
            const bool odd = (fq & 1) != 0; const int chs = pn * 64 + wc * 16 + 4 * (fq & ~1);
#pragma unroll
            for (int mp = 0; mp < 2; ++mp) { const int m0 = 2 * mp, m1 = m0 + 1;
                const u32x2 sa = odd ? a2w[m0] : a2w[m1]; const unsigned sg = odd ? gaw[m0] : gaw[m1];
                u32x2 ra; ra.x = __shfl_xor(sa.x, 16); ra.y = __shfl_xor(sa.y, 16); const unsigned rg = __shfl_xor(sg, 16);
                const int mm = odd ? m1 : m0; const size_t off = (size_t)(row0 + ai * HALF + mm * 16) * 1024 + chs;
                const u32x4 wa = odd ? (u32x4){ra.x, ra.y, a2w[m1].x, a2w[m1].y} : (u32x4){a2w[m0].x, a2w[m0].y, ra.x, ra.y};
                const u32x2 wg = odd ? (u32x2){rg, gaw[m1]} : (u32x2){gaw[m0], rg};
                if (!(q == 0 && mm == 0 && fr < 2)) *(u32x4*)(A2 + off) = wa;
                *(u32x2*)(GA + blk_index(u.pm, pn >> 2, wr * 4 + 2 * (pn & 1) + (wc >> 1), ai, (pn & 3) >> 1, mm) * 512 + ((2 * (wc & 1) + (fq >> 1)) * 16 + fr) * 8) = wg; } }
    }
};
__device__ __forceinline__ float scan_pre(float x) { x += dpp_mov<0x111>(x); x += dpp_mov<0x112>(x); x += dpp_mov<0x114>(x); x += dpp_mov<0x118>(x); return x; }
__device__ __forceinline__ float scan_suf(float x) { x += dpp_mov<0x101>(x); x += dpp_mov<0x102>(x); x += dpp_mov<0x104>(x); x += dpp_mov<0x108>(x); return x; }
template <int W> __device__ __forceinline__ float pool_sum(float pre, float sufprev) { float t1 = 0.f; if constexpr (W < 16) t1 = dpp_mov<0x110 + W>(pre); return pre - t1 + dpp_mov<0x100 + (17 - W)>(sufprev); }
struct EpiMerge {
    static constexpr bool PERM = true, AFTER_DRAIN = false;
    const unsigned char* GA; const unsigned char* GB; const bf16_t* Q; bf16_t* MG;
    template <int W> __device__ __forceinline__ void tile(const f32x4 (&acc)[2][2][4][2], const Unit& u, int wr, int wc, int fr, int fq) const {
        const int rb = u.pm * BM + wr * 64; int col0 = u.pn * BM + wc * 32 + 8 * fq;
        asm volatile("" : "+v"(col0));
        u32x4 qv[2][4], qp[2]; u32x2 ga[2][4], gb[2][4];
        const int wave_ = wr * 4 + wc, lane8_ = (fq * 16 + fr) * 8;
#define MG_LOAD(K) { const int ai_ = (K) >> 1, bj_ = (K) & 1, rblk_ = rb + ai_ * HALF; const size_t o_ = (size_t)(rblk_ + fr) * 1024 + col0 + bj_ * HALF; \
        _Pragma("unroll") for (int m = 0; m < 4; ++m) { const size_t b_ = blk_index(u.pm, u.pn, wave_, ai_, bj_, m) * 512 + lane8_; \
            qv[(K) & 1][m] = *(const u32x4*)(Q + b_); ga[(K) & 1][m] = *(const u32x2*)(GA + b_); gb[(K) & 1][m] = *(const u32x2*)(GB + b_); } \
        qp[(K) & 1] = (u32x4){0u, 0u, 0u, 0u}; \
        if ((rblk_ & 8191) != 0) qp[(K) & 1] = *(const u32x4*)(Q + blk_index(wr == 0 && ai_ == 0 ? u.pm - 1 : u.pm, u.pn, wr == 1 ? wc : 4 + wc, wr == 1 ? ai_ : 1 - ai_, bj_, 3) * 512 + lane8_); }
        MG_LOAD(0)
#pragma unroll
        for (int k = 0; k < 4; ++k) { const int ai = k >> 1, bj = k & 1, rblk = rb + ai * HALF;
            const size_t off0 = (size_t)(rblk + fr) * 1024 + col0 + bj * HALF;
            if (k < 3) MG_LOAD(k + 1)
            const u32x4 pp = qp[k & 1]; float sp[8];
            sp[0] = scan_suf(bf_lo(pp.x)); sp[1] = scan_suf(bf_hi(pp.x)); sp[2] = scan_suf(bf_lo(pp.y)); sp[3] = scan_suf(bf_hi(pp.y));
            sp[4] = scan_suf(bf_lo(pp.z)); sp[5] = scan_suf(bf_hi(pp.z)); sp[6] = scan_suf(bf_lo(pp.w)); sp[7] = scan_suf(bf_hi(pp.w));
#pragma unroll
            for (int m = 0; m < 4; ++m) { const int ts = (rblk + m * 16 + fr) & 8191;
                const float inv = (ts + 1 < W) ? __builtin_amdgcn_rcpf((float)(ts + 1)) : (1.0f / W);
                const u32x4 qq = qv[k & 1][m]; const u32x2 g_a = ga[k & 1][m], g_b = gb[k & 1][m]; float x[8];
                x[0] = bf_lo(qq.x); x[1] = bf_hi(qq.x); x[2] = bf_lo(qq.y); x[3] = bf_hi(qq.y); x[4] = bf_lo(qq.z); x[5] = bf_hi(qq.z); x[6] = bf_lo(qq.w); x[7] = bf_hi(qq.w);
                f32x4 v0, v1;
#pragma unroll
                for (int e = 0; e < 4; ++e) {
                    const float p0 = pool_sum<W>(scan_pre(x[e]), sp[e]) * inv - x[e], p1 = pool_sum<W>(scan_pre(x[4 + e]), sp[4 + e]) * inv - x[4 + e];
                    sp[e] = scan_suf(x[e]); sp[4 + e] = scan_suf(x[4 + e]);
                    v0[e] = u8f(g_a.x, e) * acc[ai][bj][m][0][e] + u8f(g_b.x, e) * p0; v1[e] = u8f(g_a.y, e) * acc[ai][bj][m][1][e] + u8f(g_b.y, e) * p1; }
                *(u32x4*)(MG + off0 + m * 16384) = pack8(v0, v1); }
            asm volatile("" ::: "memory"); }
#undef MG_LOAD
    }
    __device__ __forceinline__ void operator()(const f32x4 (&acc)[2][2][4][2], const Unit& u, int wr, int wc, int fr, int fq) const {
        if (u.pn == 0) tile<2>(acc, u, wr, wc, fr, fq); else if (u.pn == 1) tile<4>(acc, u, wr, wc, fr, fq); else if (u.pn == 2) tile<8>(acc, u, wr, wc, fr, fq); else tile<16>(acc, u, wr, wc, fr, fq);
    }
};
struct EpiZ {
    static constexpr bool PERM = false, AFTER_DRAIN = false;
    const float* x; float* z; const float* mod; f32x2* statp; float alpha;
    __device__ __forceinline__ void operator()(const f32x4 (&acc)[2][2][4][2], const Unit& u, int wr, int wc, int fr, int fq) const {
        const int row0 = u.pm * BM + wr * 64 + fr, b = (u.pm * BM) >> 13; int col0 = u.pn * BM + wc * 32 + 4 * fq;
        asm volatile("" : "+v"(col0));
        f32x4 gv[2][2];
#pragma unroll
        for (int bj = 0; bj < 2; ++bj)
#pragma unroll
            for (int n = 0; n < 2; ++n) gv[bj][n] = *(const f32x4*)(mod + b * 6144 + 2048 + col0 + bj * HALF + n * 16) + 1.0f;
        const int rowb = u.pm * BM + wr * 64, rsub = fr & 7, colx = col0 + 16 * (fr >> 3);
        f32x4 xl[3][2], xh[3][2];
#define Z_LOAD(K) { const size_t off_ = (size_t)(rowb + ((K) >> 2) * HALF + ((K) & 3) * 16 + rsub) * 1024 + colx; \
        _Pragma("unroll") for (int bj = 0; bj < 2; ++bj) { xl[(K) % 3][bj] = *(const f32x4*)(x + off_ + bj * HALF); xh[(K) % 3][bj] = *(const f32x4*)(x + off_ + 8 * 1024 + bj * HALF); } }
        Z_LOAD(0) Z_LOAD(1)
#pragma unroll
        for (int k = 0; k < 8; ++k) { const int ai = k >> 2, m = k & 3, row = row0 + ai * HALF + m * 16; const size_t off = (size_t)(rowb + ai * HALF + m * 16 + rsub) * 1024 + colx; float s = 0.f, q = 0.f;
            if (k < 6) Z_LOAD(k + 2)
#pragma unroll
            for (int bj = 0; bj < 2; ++bj) { const f32x4 XL = xl[k % 3][bj], XH = xh[k % 3][bj]; f32x4 x0, x1, ZL, ZH;
#pragma unroll
                for (int e = 0; e < 4; ++e) { x0[e] = dpp_fill<0x118>(XL[e], XH[e]); x1[e] = dpp_fill<0x108>(XH[e], XL[e]); }
                const f32x4 z0 = x0 * alpha + gv[bj][0] * acc[ai][bj][m][0], z1 = x1 * alpha + gv[bj][1] * acc[ai][bj][m][1];
                s += ((z0[0] + z0[1]) + (z0[2] + z0[3])) + ((z1[0] + z1[1]) + (z1[2] + z1[3]));
                q += ((z0[0] * z0[0] + z0[1] * z0[1]) + (z0[2] * z0[2] + z0[3] * z0[3])) + ((z1[0] * z1[0] + z1[1] * z1[1]) + (z1[2] * z1[2] + z1[3] * z1[3]));
#pragma unroll
                for (int e = 0; e < 4; ++e) { ZL[e] = dpp_fill<0x118>(z0[e], z1[e]); ZH[e] = dpp_fill<0x108>(z1[e], z0[e]); }
                *(f32x4*)(z + off + bj * HALF) = ZL; *(f32x4*)(z + off + 8 * 1024 + bj * HALF) = ZH; }
            s += __shfl_xor(s, 16); s += __shfl_xor(s, 32); q += __shfl_xor(q, 16); q += __shfl_xor(q, 32);
            if (fq == 0) statp[(size_t)row * 16 + u.pn * 4 + wc] = (f32x2){s, q};
            asm volatile("" ::: "memory"); }
#undef Z_LOAD
    }
};
__device__ __forceinline__ unsigned pk4_fp8(float a, float b, float c, float d) { int r = 0; r = __builtin_amdgcn_cvt_pk_fp8_f32(a, b, r, false); r = __builtin_amdgcn_cvt_pk_fp8_f32(c, d, r, true); return (unsigned)r; }
constexpr float W8_SCALE = 64.0f, ACT8_SCALE = 8.0f;
struct EpiGU {
    static constexpr bool PERM = true, AFTER_DRAIN = false;
    unsigned char* ACT;
    __device__ __forceinline__ void operator()(const f32x4 (&acc)[2][2][4][2], const Unit& u, int wr, int wc, int fr, int fq) const {
        const int row0 = u.pm * BM + wr * 64 + fr, col0 = (u.pn & 3) * 128 + wc * 32 + 8 * fq;
        const float is = 1.0f / W8_SCALE, os = ACT8_SCALE / W8_SCALE;
#pragma unroll
        for (int ai = 0; ai < 2; ++ai) { if (ai == 1 && u.hm) break;
#pragma unroll
            for (int m = 0; m < 4; ++m) { unsigned char* rowp = ACT + (size_t)(row0 + ai * HALF + m * 16) * 512 + col0; f32x4 v0, v1;
#pragma unroll
                for (int j = 0; j < 4; ++j) { const float g0 = acc[ai][0][m][0][j] * is, g1 = acc[ai][0][m][1][j] * is;
                    v0[j] = __builtin_fminf(__builtin_fmaxf(g0 * sigmoidf_(g0) * acc[ai][1][m][0][j] * os, -448.0f), 448.0f); v1[j] = __builtin_fminf(__builtin_fmaxf(g1 * sigmoidf_(g1) * acc[ai][1][m][1][j] * os, -448.0f), 448.0f); }
                *(u32x2*)rowp = (u32x2){pk4_fp8(v0[0], v0[1], v0[2], v0[3]), pk4_fp8(v1[0], v1[1], v1[2], v1[3])}; } }
    }
};
struct EpiDown {
    static constexpr bool PERM = true, AFTER_DRAIN = false;
    bf16_t* O; const PG8_LAS u32x2* rs;
    __device__ __forceinline__ void operator()(const f32x4 (&acc)[2][2][4][2], const Unit& u, int wr, int wc, int fr, int fq) const {
        asm volatile("" : "+v"(fr), "+v"(fq));
        const int colx = (u.pn & 3) * 256 + wc * 64 + 32 * (fr >> 3) + 8 * fq;
        const PG8_LAS unsigned* tb = (const PG8_LAS unsigned*)(rs + u.ord * 256 + wr * 64);
#pragma unroll
        for (int ai = 0; ai < 2; ++ai) { if (ai == 1 && u.hm) break;
#pragma unroll
            for (int m = 0; m < 4; ++m) { const int rb = ai * HALF + m * 16;
                const float wt = __builtin_bit_cast(float, tb[(rb + fr) * 2 + 1]) * (1.0f / (W8_SCALE * ACT8_SCALE));
                const int slo = (int)tb[(rb + (fr & 7)) * 2], shi = (int)tb[(rb + 8 + (fr & 7)) * 2];
                const u32x4 p0 = pack8(acc[ai][0][m][0] * wt, acc[ai][0][m][1] * wt), p1 = pack8(acc[ai][1][m][0] * wt, acc[ai][1][m][1] * wt);
                u32x4 sl, sh;
                sl.x = dpp_fillu<0x118>(p0.x, p1.x); sl.y = dpp_fillu<0x118>(p0.y, p1.y); sl.z = dpp_fillu<0x118>(p0.z, p1.z); sl.w = dpp_fillu<0x118>(p0.w, p1.w);
                sh.x = dpp_fillu<0x108>(p1.x, p0.x); sh.y = dpp_fillu<0x108>(p1.y, p0.y); sh.z = dpp_fillu<0x108>(p1.z, p0.z); sh.w = dpp_fillu<0x108>(p1.w, p0.w);
                if (slo >= 0) *(u32x4*)(O + (size_t)slo * 1024 + colx) = sl;
                if (shi >= 0) *(u32x4*)(O + (size_t)shi * 1024 + colx) = sh; } }
    }
};
struct MoeOrder {
    int G, vc, nunits, nfull; const PG8_LAS int* tinfo;
    __device__ __forceinline__ bool next(int i, Unit& u) const { const int L = i * G + vc; if (L >= nunits) return false; const int k = L >> 2, ti = tinfo[k];
        u.pm = ti & 0xffff; u.pn = (ti >> 16) * 4 + (L & 3); u.ord = i; u.hm = k >= nfull ? 1 : 0; return true; }
    __device__ __forceinline__ void a_ready(const Unit&) const {}
    __device__ __forceinline__ void done(const Unit&) const {}
};

struct NoPost { __device__ __forceinline__ void operator()(int) const {} };
typedef int i32x8 __attribute__((ext_vector_type(8))); typedef int i32x4 __attribute__((ext_vector_type(4)));
template <class Epi, class Sched, bool ALIGN_EPI = false, bool SP2 = false, bool GATHER = false, class Post = NoPost, bool FP8 = false>
__device__ __forceinline__ void gemm_phase(PG8_LAS unsigned char* lds, const Gemm g, const Sched& S, const Epi& E, const PG8_LAS unsigned short* toks = nullptr, const Post& PP = Post()) {
    static_assert(!GATHER || SP2, "gather is written for the SP2 loop only");
    int tid = threadIdx.x; asm volatile("" : "+v"(tid));
    const int wid = __builtin_amdgcn_readfirstlane(tid >> 6), lane = tid & 63, wr = wid >> 2, wc = wid & 3, fr = lane & 15, fq = lane >> 4;
    const int K = g.K, nt = K / BK;
    unsigned voffA[2], voffB[2];
#pragma unroll
    for (int i = 0; i < 2; ++i) { int R, C; stage_rc(tid * 16 + i * 8192, R, C); const int Rb = Epi::PERM ? ((R & ~31) + perm32(R & 31)) : R;
        voffA[i] = (unsigned)(R * K + C) * 2u; voffB[i] = (unsigned)(Rb * K + C) * 2u; }
    const size_t kstep = (size_t)(BK * 2);
    const size_t hstep = (size_t)HALF * K * 2;
    const size_t tstep = 2 * hstep;
    const unsigned ldsw = (unsigned)wid * 1024u;
    const int aoff = lds_byte(wr * 64 + fr, fq * 8), boff = lds_byte(wc * 32 + fr, fq * 8);
#define PG8_SA(b, h) (((b) * 2 + (h)) * HTB)
#define PG8_SB(b, h) ((4 + (b) * 2 + (h)) * HTB)
    const __amdgpu_buffer_rsrc_t rsA = __builtin_amdgcn_make_buffer_rsrc((void*)g.A, 0, (int)0xFFFFFFF0u, 0x00020000), rsB = __builtin_amdgcn_make_buffer_rsrc((void*)g.Bt, 0, (int)0xFFFFFFF0u, 0x00020000);
#define PG8_STAGE_X(rs, base, bufoff, gbase, voff) do { const unsigned _so = (unsigned)((const char*)(gbase) - (const char*)(base)); _Pragma("unroll") for (int _i = 0; _i < 2; ++_i) \
        __builtin_amdgcn_raw_ptr_buffer_load_lds(rs, (PG8_LAS unsigned*)(lds + (bufoff) + ldsw + _i * 8192), 16, (voff)[_i], _so, 0, 0); } while (0)
#define PG8_STAGE_A(bufoff, gbase) PG8_STAGE_X(rsA, g.A, bufoff, gbase, voffA)
#define PG8_STAGE_B(bufoff, gbase) PG8_STAGE_X(rsB, g.Bt, bufoff, gbase, voffB)
    unsigned vAc[2][2];
#define PG8_TOKL(j, h, _i) ({ int _R2, _C2; stage_rc(tid * 16 + (_i) * 8192, _R2, _C2); (unsigned)toks[(j) * BM + (h) * HALF + _R2] * (unsigned)(K * 2) + (unsigned)(_C2 * 2); })
#define PG8_STAGE_G(bufoff, kb, v, h) do { _Pragma("unroll") for (int _i = 0; _i < 2; ++_i) \
        __builtin_amdgcn_raw_ptr_buffer_load_lds(rsA, (PG8_LAS unsigned*)(lds + (bufoff) + ldsw + _i * 8192), 16, (v)[h][_i], (unsigned)(kb), 0, 0); } while (0)
#define PG8_STAGE_G2(bufoff, kb, h) do { _Pragma("unroll") for (int _i = 0; _i < 2; ++_i) { unsigned _o = vAc[h][_i]; if (last) _o = PG8_TOKL(has_next ? ui + 1 : ui, h, _i); \
        __builtin_amdgcn_raw_ptr_buffer_load_lds(rsA, (PG8_LAS unsigned*)(lds + (bufoff) + ldsw + _i * 8192), 16, _o, (unsigned)(kb), 0, 0); } } while (0)
#define PG8_LDA(dst, b, h) do { if constexpr (FP8) { _Pragma("unroll") for (int m = 0; m < 4; ++m) { const i32x4 _lo = *(const PG8_LAS i32x4*)(lds + PG8_SA(b, h) + aoff + m * 2048), _hi = *(const PG8_LAS i32x4*)(lds + PG8_SA(b, h) + aoff + m * 2048 + 1024); \
            dst##8[m] = __builtin_shufflevector(_lo, _hi, 0, 1, 2, 3, 4, 5, 6, 7); } } \
        else { _Pragma("unroll") for (int m = 0; m < 4; ++m) _Pragma("unroll") for (int k = 0; k < 2; ++k) dst[m][k] = *(const PG8_LAS bf16x8*)(lds + PG8_SA(b, h) + aoff + m * 2048 + k * 1024); } } while (0)
#define PG8_LDB(dst, b, h) do { if constexpr (FP8) { _Pragma("unroll") for (int n = 0; n < 2; ++n) { const i32x4 _lo = *(const PG8_LAS i32x4*)(lds + PG8_SB(b, h) + boff + n * 2048), _hi = *(const PG8_LAS i32x4*)(lds + PG8_SB(b, h) + boff + n * 2048 + 1024); \
            dst##8[n] = __builtin_shufflevector(_lo, _hi, 0, 1, 2, 3, 4, 5, 6, 7); } } \
        else { _Pragma("unroll") for (int n = 0; n < 2; ++n) _Pragma("unroll") for (int k = 0; k < 2; ++k) dst[n][k] = *(const PG8_LAS bf16x8*)(lds + PG8_SB(b, h) + boff + n * 2048 + k * 1024); } } while (0)
#define PG8_MMA(ai, bj, At, Bt) do { __builtin_amdgcn_s_setprio(1); \
        if constexpr (FP8) { _Pragma("unroll") for (int m = 0; m < 4; ++m) _Pragma("unroll") for (int n = 0; n < 2; ++n) \
            acc[ai][bj][m][n] = __builtin_amdgcn_mfma_scale_f32_16x16x128_f8f6f4(Bt##8[n], At##8[m], acc[ai][bj][m][n], 0, 0, 0, 0, 0, 0); } \
        else { _Pragma("unroll") for (int m = 0; m < 4; ++m) _Pragma("unroll") for (int n = 0; n < 2; ++n) _Pragma("unroll") for (int k = 0; k < 2; ++k) \
            acc[ai][bj][m][n] = __builtin_amdgcn_mfma_f32_16x16x32_bf16(Bt[n][k], At[m][k], acc[ai][bj][m][n], 0, 0, 0); } \
        __builtin_amdgcn_s_setprio(0); } while (0)
#define PG8_WAIT_V(n) asm volatile("s_waitcnt vmcnt(" #n ")" ::: "memory")
#define PG8_WAIT_L(n) asm volatile("s_waitcnt lgkmcnt(" #n ")" ::: "memory")
#define PG8_BAR __builtin_amdgcn_s_barrier()
#define PG8_SCHED __builtin_amdgcn_sched_barrier(0)
    Unit cur, nxt; int ui = 0;
    if (!S.next(0, cur)) return;
    f32x4 acc[2][2][4][2];
#pragma unroll
    for (int a = 0; a < 2; ++a)
#pragma unroll
        for (int b = 0; b < 2; ++b)
#pragma unroll
            for (int m = 0; m < 4; ++m)
#pragma unroll
                for (int n = 0; n < 2; ++n) acc[a][b][m][n] = (f32x4){0.f, 0.f, 0.f, 0.f};
    bf16x8 At[4][2], B0[2][2], B1[2][2]; i32x8 At8[4], B08[2], B18[2];
    const char* cA = (const char*)g.A + (size_t)cur.pm * tstep; const char* cB = (const char*)g.Bt + (size_t)cur.pn * tstep;
    S.a_ready(cur);
    if constexpr (SP2) {
        if constexpr (GATHER) {
#pragma unroll
            for (int _h = 0; _h < 2; ++_h) { vAc[_h][0] = PG8_TOKL(0, _h, 0); vAc[_h][1] = PG8_TOKL(0, _h, 1); }
            PG8_STAGE_B(PG8_SB(0, 0), cB); PG8_STAGE_B(PG8_SB(0, 1), cB + hstep); PG8_STAGE_G(PG8_SA(0, 0), 0, vAc, 0); PG8_STAGE_G(PG8_SA(0, 1), 0, vAc, 1);
        } else {
        PG8_STAGE_B(PG8_SB(0, 0), cB); PG8_STAGE_B(PG8_SB(0, 1), cB + hstep); PG8_STAGE_A(PG8_SA(0, 0), cA); PG8_STAGE_A(PG8_SA(0, 1), cA + hstep);
        }
        if (wr == 1) PG8_BAR;
        PG8_WAIT_V(2); PG8_BAR;
        if constexpr (GATHER) { PG8_STAGE_B(PG8_SB(1, 0), cB + kstep); PG8_STAGE_G(PG8_SA(1, 0), kstep, vAc, 0); PG8_STAGE_B(PG8_SB(1, 1), cB + hstep + kstep); }
        else {
        PG8_STAGE_B(PG8_SB(1, 0), cB + kstep); PG8_STAGE_A(PG8_SA(1, 0), cA + kstep); PG8_STAGE_B(PG8_SB(1, 1), cB + hstep + kstep);
        }
        PG8_WAIT_V(6); PG8_BAR;
    } else {
        PG8_STAGE_B(PG8_SB(0, 0), cB); PG8_STAGE_A(PG8_SA(0, 0), cA); PG8_STAGE_B(PG8_SB(0, 1), cB + hstep); PG8_STAGE_A(PG8_SA(0, 1), cA + hstep);
        if (wr == 1) PG8_BAR;
        PG8_WAIT_V(4); PG8_BAR;
        PG8_STAGE_B(PG8_SB(1, 0), cB + kstep); PG8_STAGE_A(PG8_SA(1, 0), cA + kstep); PG8_STAGE_B(PG8_SB(1, 1), cB + hstep + kstep);
        PG8_WAIT_V(6); PG8_BAR;
    }
    for (;;) {
        const bool has_next = S.next(ui + 1, nxt);
        const char* nA = has_next ? (const char*)g.A + (size_t)nxt.pm * tstep : cA; const char* nB = has_next ? (const char*)g.Bt + (size_t)nxt.pn * tstep : cB;
#pragma clang loop unroll(disable)
        for (int t = 0; t < nt; t += 2) {
            const bool last = (t == nt - 2);
            const char* a1 = cA + (size_t)(t + 1) * kstep;
            const char* a2 = last ? nA : cA + (size_t)(t + 2) * kstep; const char* b2 = last ? nB : cB + (size_t)(t + 2) * kstep;
            const char* a3 = a2 + kstep; const char* b3 = b2 + kstep;
            if (last && has_next) S.a_ready(nxt);
            const size_t kb2 = last ? (size_t)0 : (size_t)(t + 2) * kstep;
            if constexpr (SP2) {
            PG8_LDB(B0, 0, 0); PG8_LDB(B1, 0, 1); PG8_SCHED; PG8_LDA(At, 0, 0); if constexpr (GATHER) PG8_STAGE_G(PG8_SA(1, 1), (size_t)(t + 1) * kstep, vAc, 1); else PG8_STAGE_A(PG8_SA(1, 1), a1 + hstep);
            PG8_WAIT_V(8); PG8_WAIT_L(0); PG8_BAR; PG8_MMA(0, 0, At, B0); PG8_MMA(0, 1, At, B1); PG8_BAR; PG8_SCHED;
            if (!cur.hm) PG8_LDA(At, 0, 1); PG8_STAGE_B(PG8_SB(0, 0), b2); PG8_STAGE_B(PG8_SB(0, 1), b2 + hstep); if constexpr (GATHER) PG8_STAGE_G2(PG8_SA(0, 0), kb2, 0); else PG8_STAGE_A(PG8_SA(0, 0), a2);
            PG8_WAIT_V(8); PG8_WAIT_L(0); PG8_BAR; if (!cur.hm) { PG8_MMA(1, 0, At, B0); PG8_MMA(1, 1, At, B1); } PG8_BAR; PG8_SCHED;
            PG8_LDB(B0, 1, 0); PG8_LDB(B1, 1, 1); PG8_SCHED; PG8_LDA(At, 1, 0); if constexpr (GATHER) PG8_STAGE_G2(PG8_SA(0, 1), kb2, 1); else PG8_STAGE_A(PG8_SA(0, 1), a2 + hstep);
            PG8_WAIT_V(8); PG8_WAIT_L(0); PG8_BAR; PG8_MMA(0, 0, At, B0); PG8_MMA(0, 1, At, B1); PG8_BAR; PG8_SCHED;
            if (!cur.hm) PG8_LDA(At, 1, 1); PG8_STAGE_B(PG8_SB(1, 0), b3); PG8_STAGE_B(PG8_SB(1, 1), b3 + hstep); if constexpr (GATHER) PG8_STAGE_G2(PG8_SA(1, 0), kb2 + kstep, 0); else PG8_STAGE_A(PG8_SA(1, 0), a3);
            PG8_WAIT_V(8); PG8_WAIT_L(0); PG8_BAR; if (!cur.hm) { PG8_MMA(1, 0, At, B0); PG8_MMA(1, 1, At, B1); } PG8_BAR; PG8_SCHED;
            } else {
            PG8_LDB(B0, 0, 0); PG8_SCHED; PG8_LDA(At, 0, 0); PG8_STAGE_A(PG8_SA(1, 1), a1 + hstep);
            PG8_WAIT_L(8); PG8_BAR; PG8_WAIT_L(0); PG8_MMA(0, 0, At, B0); PG8_BAR; PG8_SCHED;
            PG8_LDB(B1, 0, 1); PG8_STAGE_B(PG8_SB(0, 0), b2);
            PG8_BAR; PG8_WAIT_L(0); PG8_MMA(0, 1, At, B1); PG8_BAR;
            PG8_LDA(At, 0, 1); PG8_STAGE_A(PG8_SA(0, 0), a2);
            PG8_BAR; PG8_WAIT_L(0); PG8_MMA(1, 0, At, B0); PG8_BAR; PG8_SCHED;
            PG8_STAGE_B(PG8_SB(0, 1), b2 + hstep);
            PG8_WAIT_V(6); PG8_BAR; PG8_MMA(1, 1, At, B1); PG8_BAR;
            PG8_LDB(B0, 1, 0); PG8_SCHED; PG8_LDA(At, 1, 0); PG8_STAGE_A(PG8_SA(0, 1), a2 + hstep);
            PG8_WAIT_L(8); PG8_BAR; PG8_WAIT_L(0); PG8_MMA(0, 0, At, B0); PG8_BAR; PG8_SCHED;
            PG8_LDB(B1, 1, 1); PG8_STAGE_B(PG8_SB(1, 0), b3);
            PG8_BAR; PG8_WAIT_L(0); PG8_MMA(0, 1, At, B1); PG8_BAR;
            PG8_LDA(At, 1, 1); PG8_STAGE_A(PG8_SA(1, 0), a3);
            PG8_BAR; PG8_WAIT_L(0); PG8_MMA(1, 0, At, B0); PG8_BAR; PG8_SCHED;
            PG8_STAGE_B(PG8_SB(1, 1), b3 + hstep);
            PG8_WAIT_V(6); PG8_BAR; PG8_MMA(1, 1, At, B1); PG8_BAR;
            }
        }
        if constexpr (ALIGN_EPI) { if (wr == 0) PG8_BAR; }
        if constexpr (!Epi::AFTER_DRAIN) { E(acc, cur, wr, wc, fr, fq); S.done(cur); }
        PP(ui);
        if (!has_next) break;
#pragma unroll
        for (int a = 0; a < 2; ++a)
#pragma unroll
            for (int b = 0; b < 2; ++b)
#pragma unroll
                for (int m = 0; m < 4; ++m)
#pragma unroll
                    for (int n = 0; n < 2; ++n) acc[a][b][m][n] = (f32x4){0.f, 0.f, 0.f, 0.f};
        cur = nxt; cA = nA; cB = nB; ++ui;
        if constexpr (GATHER) {
#pragma unroll
            for (int _h = 0; _h < 2; ++_h) { vAc[_h][0] = PG8_TOKL(ui, _h, 0); vAc[_h][1] = PG8_TOKL(ui, _h, 1); } }
        if constexpr (ALIGN_EPI) { if (wr == 1) PG8_BAR; }
    }
    PG8_WAIT_V(0);
    if constexpr (!ALIGN_EPI) { if (wr == 0) PG8_BAR; }
    PG8_BAR;
    if constexpr (Epi::AFTER_DRAIN) { E.fused(acc, cur, wr, wc, fr, fq, lds, wid, lane); S.done(cur); }
#undef PG8_SA
#undef PG8_SB
#undef PG8_STAGE_X
#undef PG8_STAGE_A
#undef PG8_STAGE_B
#undef PG8_STAGE_G
#undef PG8_STAGE_G2
#undef PG8_TOKL
#undef PG8_LDA
#undef PG8_LDB
#undef PG8_MMA
#undef PG8_WAIT_V
#undef PG8_WAIT_L
#undef PG8_BAR
#undef PG8_SCHED
}
}

#define GAS __attribute__((address_space(1)))
#define LAS __attribute__((address_space(3)))
typedef unsigned short bf16;
typedef unsigned v4u __attribute__((ext_vector_type(4)));
typedef unsigned v2u __attribute__((ext_vector_type(2)));
typedef float f32x4 __attribute__((ext_vector_type(4)));
typedef float f32x2 __attribute__((ext_vector_type(2)));
typedef short bf16x8 __attribute__((ext_vector_type(8)));
typedef GAS unsigned gu32;
#define RLX_AGENT __ATOMIC_RELAXED, __HIP_MEMORY_SCOPE_AGENT
#define LDS_WAIT() asm volatile("s_waitcnt lgkmcnt(0)" ::: "memory")
#define VM_WAIT() asm volatile("s_waitcnt vmcnt(0)" ::: "memory")
__device__ __forceinline__ unsigned f2bf(float f) { unsigned u = __builtin_bit_cast(unsigned, f); return (u + 0x7fffu + ((u >> 16) & 1u)) >> 16; }
__device__ __forceinline__ unsigned pk2(float lo, float hi) { return f2bf(lo) | (f2bf(hi) << 16); }
__device__ __forceinline__ float bflo(unsigned w) { return __builtin_bit_cast(float, w << 16); }
__device__ __forceinline__ float bfhi(unsigned w) { return __builtin_bit_cast(float, w & 0xffff0000u); }
__device__ __forceinline__ float wave_sum(float v) {
#pragma unroll
    for (int o = 1; o < 64; o <<= 1) v += __shfl_xor(v, o);
    return v;
}

#define XB_TMO      128
#define XB_XCNT(j)  (256  + 64 * (j))
#define XB_XSUB(j)  (1280 + 64 * (j))
#define XB_XGEN(j)  (2304 + 64 * (j))
#define XB_TOP      3328
#define XB_TOPGEN   3392
#define XCD_BAR_WORDS 3456
#define XB_SPIN_CAP (1u << 18)

__device__ __forceinline__ unsigned xb_ld(unsigned* p)              { return __hip_atomic_load(p, __ATOMIC_RELAXED, __HIP_MEMORY_SCOPE_AGENT); }
__device__ __forceinline__ unsigned xb_add(unsigned* p, unsigned v) { return __hip_atomic_fetch_add(p, v, __ATOMIC_RELAXED, __HIP_MEMORY_SCOPE_AGENT); }
__device__ __forceinline__ unsigned xb_xcc_id() { return (unsigned)__builtin_amdgcn_s_getreg((3 << 11) | 20) & 0xFu; }
#define XB_SPIN(cond, bar) do { unsigned _sp = 0; while (cond) { __builtin_amdgcn_s_sleep(1); \
    if ((++_sp & 255u) == 0u) { if (xb_ld(&(bar)[XB_TMO])) break; if (_sp > XB_SPIN_CAP) { atomicAdd(&(bar)[XB_TMO], 1u); break; } } } } while (0)

struct XcdBarrier {
    unsigned* bar; unsigned x;
    volatile LAS unsigned* st;
};

__device__ __forceinline__ XcdBarrier xcd_barrier_post(unsigned* bar, volatile LAS unsigned* st) {
    XcdBarrier b; b.bar = bar; b.x = xb_xcc_id(); b.st = st;
    if (threadIdx.x == 0) (void)xb_add(&bar[XB_XCNT(b.x)], 1u);
    return b;
}
__device__ __forceinline__ void xcd_barrier_complete(unsigned* bar, unsigned x, unsigned& nloc, unsigned& nx) {
    const unsigned G = gridDim.x * gridDim.y * gridDim.z;
    unsigned sum, cnt, mine, sp = 0u;
    for (;;) {
        sum = 0u; cnt = 0u; mine = 0u;
#pragma unroll
        for (unsigned j = 0; j < 16; ++j) { const unsigned c = xb_ld(&bar[XB_XCNT(j)]); sum += c; cnt += (c > 0u) ? 1u : 0u; mine = (j == x) ? c : mine; }
        if (sum == G) break;
        __builtin_amdgcn_s_sleep(1);
        if ((++sp & 255u) == 0u) { if (xb_ld(&bar[XB_TMO])) break; if (sp > XB_SPIN_CAP) { atomicAdd(&bar[XB_TMO], 1u); break; } }
    }
    nloc = mine > 0u ? mine : 1u; nx = cnt > 0u ? cnt : 1u;
}

__device__ __forceinline__ void xcd_barrier(const XcdBarrier& b) {
    asm volatile("s_waitcnt vmcnt(0)" ::: "memory");
    __syncthreads();
    if (threadIdx.x == 0) {
        unsigned* bar = b.bar;
        __builtin_amdgcn_s_waitcnt(0);
        unsigned nloc = b.st[0], nx = b.st[1];
        if (nloc == 0u) { xcd_barrier_complete(bar, b.x, nloc, nx); b.st[0] = nloc; b.st[1] = nx; }
        const unsigned old = xb_add(&bar[XB_XSUB(b.x)], 1u);
        const unsigned gen = old / nloc;
        if (old + 1u == (gen + 1u) * nloc) {
            __builtin_amdgcn_fence(__ATOMIC_RELEASE, "agent");
            asm volatile("s_waitcnt vmcnt(0)" ::: "memory");
            const unsigned og = xb_add(&bar[XB_TOP], 1u);
            const unsigned tg = og / nx;
            if (og + 1u == (tg + 1u) * nx) xb_add(&bar[XB_TOPGEN], 1u);
            else XB_SPIN(xb_ld(&bar[XB_TOPGEN]) == tg, bar);
            __builtin_amdgcn_fence(__ATOMIC_ACQUIRE, "agent");
            xb_add(&bar[XB_XGEN(b.x)], 1u);
            asm volatile("s_waitcnt vmcnt(0)" ::: "memory");
        } else {
            XB_SPIN(xb_ld(&bar[XB_XGEN(b.x)]) == gen, bar);
            __builtin_amdgcn_fence(__ATOMIC_ACQUIRE, "agent");
            asm volatile("s_waitcnt vmcnt(0)" ::: "memory");
        }
    }
    __syncthreads();
}

constexpr int NWAVES = 8;
constexpr int D = 1024, NBATCH = 4, T = 8192, M = NBATCH * T;
constexpr int NPROJ = 6144, NE = 64, DE = 512;
constexpr int CAP = 2 * M + NE * 256;
constexpr int NBLK = M / 128;
constexpr float LN_EPS = 1e-5f;
constexpr float ALPHA = 1.18920711500272f;
constexpr size_t MiB = 1u << 20;
constexpr size_t WS_CTL = 0, CTL_ZERO_BYTES = 65536;
constexpr int NKC = 8;
constexpr size_t WS_MODP = 96 * MiB;
constexpr size_t WS_MOD = 1 * MiB + 512 * 1024;
constexpr size_t WS_GCBC = 1 * MiB + 768 * 1024;
constexpr size_t WS_RW = 2 * MiB;
constexpr size_t WS_WGCNT = 2 * MiB + 512 * 1024;
constexpr size_t WS_TOKINFO = 3 * MiB;
constexpr size_t WS_ROWSLOT = 3 * MiB + 512 * 1024;
constexpr size_t WS_ROWWT = 4 * MiB;
constexpr size_t WS_ROWTOK = 4 * MiB + 512 * 1024;
constexpr size_t WS_STATP = 5 * MiB;
constexpr size_t WS_RAW = 26 * MiB;
constexpr size_t WS_WIN = 10 * MiB, WS_WOC = 22 * MiB, WS_WO = 24 * MiB, WS_WGU = 32 * MiB, WS_WD = 160 * MiB;
constexpr size_t WS_U = 224 * MiB, WS_A2 = WS_U, WS_H = WS_U;
constexpr size_t WS_Q = 288 * MiB, WS_MG = 480 * MiB;
constexpr size_t WS_GA = 352 * MiB, WS_GB = 416 * MiB, WS_PQG = 480 * MiB;
constexpr size_t WS_ACT = 480 * MiB, WS_O = 352 * MiB;
constexpr size_t WS_END = 560 * MiB;
static_assert(WS_ACT + (size_t)CAP * DE * 2 <= 560 * MiB && WS_O + (size_t)2 * M * D * 2 <= WS_ACT, "d_ws map");
constexpr int CW_TMO = 0, CW_BAR = 1024;
constexpr int RING_OFF = 0, RING_BYTES = 131072;
constexpr int MISC_OFF = 135168;
constexpr int LT_PADSTART = MISC_OFF + 128;
constexpr int LT_TILEE = MISC_OFF + 512;
constexpr int LT_HIST = MISC_OFF + 2048;
constexpr int LT_TOT = MISC_OFF + 2304, LT_BASE = MISC_OFF + 2560;
constexpr int LT_AE = MISC_OFF + 3072, LT_APOS = MISC_OFF + 4096;
constexpr int LT_PSUM = MISC_OFF + 5120;
constexpr int LT_CONVW = 147456;
constexpr int LDS_BYTES = 159744;
static_assert(LT_PSUM + 4096 <= LDS_BYTES && LT_HIST + 5 * 256 * 8 <= LDS_BYTES, "LDS map");

struct Frame {
    LAS unsigned char* lds; unsigned char* ldsg;
    gu32* ctl;
    int tid, lane, wave, G;
    const float *x, *c, *w_ada, *b_ada, *w_in, *conv_w, *w_out_conv, *w_pool, *pool_scale, *w_o, *ln1_g, *ln1_b, *w_group, *b_group, *w_router, *b_router, *w_gate, *w_up, *w_down, *ln2_g, *ln2_b;
    float* out; unsigned char* ws;
};

__device__ __forceinline__ void p0a_mod(Frame& F) {
    LAS float* sc = (LAS float*)(F.lds);
    LAS float* red = (LAS float*)(F.lds + 16384);
    float* modp = (float*)(F.ws + WS_MODP);
    float w[3][16];
#pragma unroll
    for (int r = 0; r < 3; ++r) { const int u = blockIdx.x + r * F.G; if (u < NKC * 96) { const int cg = u >> 3, kc = u & 7;
        const float* wp = F.w_ada + (size_t)(kc * 128 + F.wave * 16) * NPROJ + cg * 64 + F.lane;
#pragma unroll
        for (int i = 0; i < 16; ++i) w[r][i] = __builtin_nontemporal_load(wp + (size_t)i * NPROJ); } }
    { float cv[8];
#pragma unroll
      for (int i = 0; i < 8; ++i) cv[i] = F.c[F.tid + 512 * i];
#pragma unroll
      for (int i = 0; i < 8; ++i) sc[F.tid + 512 * i] = cv[i] / (1.0f + __expf(-cv[i])); }
    __syncthreads();
#pragma unroll
    for (int r = 0; r < 3; ++r) { const int u = blockIdx.x + r * F.G; if (u >= NKC * 96) break;
        const int cg = u >> 3, kc = u & 7, k0 = kc * 128 + F.wave * 16;
        float a0 = 0.f, a1 = 0.f, a2 = 0.f, a3 = 0.f;
#pragma unroll
        for (int i = 0; i < 16; ++i) { const int k = k0 + i; a0 += sc[k] * w[r][i]; a1 += sc[1024 + k] * w[r][i]; a2 += sc[2048 + k] * w[r][i]; a3 += sc[3072 + k] * w[r][i]; }
        red[(F.wave * 4 + 0) * 64 + F.lane] = a0; red[(F.wave * 4 + 1) * 64 + F.lane] = a1; red[(F.wave * 4 + 2) * 64 + F.lane] = a2; red[(F.wave * 4 + 3) * 64 + F.lane] = a3;
        __syncthreads();
        if (F.wave < 4) { float s = 0.f;
#pragma unroll
            for (int w8 = 0; w8 < 8; ++w8) s += red[(w8 * 4 + F.wave) * 64 + F.lane];
            modp[((size_t)kc * 4 + F.wave) * NPROJ + cg * 64 + F.lane] = s; }
        __syncthreads();
    }
}

__device__ __forceinline__ int conv_row(int tau, int c) { return 128 * (tau >> 1) + 32 * (c >> 4) + 8 * ((c >> 2) & 3) + 4 * (tau & 1) + (c & 3); }
__device__ __forceinline__ void transpose_item(const float* W, int ld, int src_col0, bf16* dst, int K, int dst_row0, int k0, LAS float* scr, int lane, int tau = -1) {
    float tv[64]; const float* wsrc = W + (size_t)k0 * ld + src_col0 + lane;
#pragma unroll
    for (int i = 0; i < 64; ++i) tv[i] = wsrc[(size_t)i * ld];
#pragma unroll
    for (int i = 0; i < 64; ++i) scr[i * 65 + lane] = tv[i];
    LDS_WAIT(); asm volatile("" ::: "memory");
    const int c = lane & 7, nn = lane >> 3;
#pragma unroll
    for (int j = 0; j < 8; ++j) { const int n = nn + 8 * j; const LAS float* s = scr + (8 * c) * 65 + n;
        v4u o; o.x = pk2(s[0 * 65], s[1 * 65]); o.y = pk2(s[2 * 65], s[3 * 65]); o.z = pk2(s[4 * 65], s[5 * 65]); o.w = pk2(s[6 * 65], s[7 * 65]);
        const int drow = dst_row0 + (tau < 0 ? n : conv_row(tau, n));
        *(GAS v4u*)(dst + (size_t)drow * K + k0 + 8 * c) = o; }
    LDS_WAIT(); asm volatile("" ::: "memory");
}
constexpr int NT_ITEMS = 1280 + 256 + 256;
__device__ __forceinline__ void p0b_transpose(Frame& F, int it, LAS float* scr) {
    bf16* WinT = (bf16*)(F.ws + WS_WIN);
    if (it < 1280) { const int seg = it >> 8, r = it & 255, kb = r >> 4, nb = r & 15;
        if (seg < 4) transpose_item(F.w_in, NPROJ, (seg == 0 ? 0 : seg == 1 ? 2048 : seg == 2 ? 1024 : 4096) + 64 * nb, WinT, D, 256 * nb, 64 * kb, scr, F.lane, seg);
        else transpose_item(F.w_in, NPROJ, 5120 + 64 * nb, WinT, D, 5120 + 64 * nb, 64 * kb, scr, F.lane);
        return; }
    it -= 1280;
    if (it < 256) { const int kb = it >> 4, nb = it & 15; transpose_item(F.w_out_conv, D, 64 * nb, (bf16*)(F.ws + WS_WOC), D, 64 * nb, 64 * kb, scr, F.lane); return; }
    it -= 256;
    if (it < 256) { const int kb = it >> 4, nb = it & 15; transpose_item(F.w_o, D, 64 * nb, (bf16*)(F.ws + WS_WO), D, 64 * nb, 64 * kb, scr, F.lane); return; }
}
constexpr int NCONV = 32;
struct XItem { const float* src; unsigned char* dst; int ld, K, r1; };
__device__ __forceinline__ XItem expert_item(Frame& F, int j) {
    XItem x; const int half = (j >> 11) & 1; int p = ((j >> 12) << 11) | (j & 2047);
    if (p < 8192) { const int up = p >= 4096 ? 1 : 0; p &= 4095; const int e = p >> 6, r = p & 63, kb = 2 * (r >> 3) + half, nb = r & 7;
        x.ld = DE; x.K = D; x.src = (up ? F.w_up : F.w_gate) + (size_t)e * D * DE + (size_t)(64 * kb) * DE + 64 * nb;
        x.r1 = 32; x.dst = (F.ws + WS_WGU) + (size_t)e * D * D + (size_t)(256 * (nb >> 1) + 128 * up + 64 * (nb & 1)) * D + 128 * (r >> 3); return x; }
    p -= 8192;
    { const int e = p >> 6, r = p & 63, kb = 2 * (r >> 4) + half, nb = r & 15;
        x.ld = D; x.K = DE; x.src = F.w_down + (size_t)e * DE * D + (size_t)(64 * kb) * D + 64 * nb;
        x.r1 = 128; x.dst = (F.ws + WS_WD) + (size_t)e * D * DE + (size_t)(256 * (nb >> 2) + 32 * (nb & 3)) * DE + 128 * (r >> 4); return x; }
}
__device__ __forceinline__ void xitem_load(const XItem& x, float (&tv)[64], int lane) {
    const float* wsrc = x.src + lane;
#pragma unroll
    for (int i = 0; i < 64; ++i) tv[i] = __builtin_nontemporal_load(wsrc + (size_t)i * x.ld);
}
__device__ __forceinline__ void xitem_pack(const float (&tv)[64], LAS float* scr, int lane, v2u (&o)[8]) {
#pragma unroll
    for (int i = 0; i < 64; ++i) scr[i * 65 + lane] = tv[i];
    LDS_WAIT(); asm volatile("" ::: "memory");
    const int c = lane & 7, nn = lane >> 3;
#pragma unroll
    for (int j = 0; j < 8; ++j) { const int n = nn + 8 * j; const LAS float* sp = scr + (8 * c) * 65 + n;
        const float ws_ = pg8::W8_SCALE;
        o[j] = (v2u){pg8::pk4_fp8(sp[0 * 65] * ws_, sp[1 * 65] * ws_, sp[2 * 65] * ws_, sp[3 * 65] * ws_), pg8::pk4_fp8(sp[4 * 65] * ws_, sp[5 * 65] * ws_, sp[6 * 65] * ws_, sp[7 * 65] * ws_)}; }
    LDS_WAIT(); asm volatile("" ::: "memory");
}
__device__ __forceinline__ void xpair_store(const XItem& x, const v2u (&oa)[8], const v2u (&ob)[8], int lane) {
    const int c = lane & 7, nn = lane >> 3; const bool odd = (c & 1) != 0;
#pragma unroll
    for (int j = 0; j < 8; ++j) { const int n = nn + 8 * j; const v2u snd = odd ? oa[j] : ob[j]; v2u rcv; rcv.x = __shfl_xor(snd.x, 1); rcv.y = __shfl_xor(snd.y, 1);
        const v4u w = odd ? (v4u){rcv.x, rcv.y, ob[j].x, ob[j].y} : (v4u){oa[j].x, oa[j].y, rcv.x, rcv.y};
        __builtin_nontemporal_store(w, (GAS v4u*)(x.dst + (size_t)((n & 31) + (n >> 5) * x.r1) * x.K + (odd ? 64 + 8 * (c - 1) : 8 * c))); }
}
__device__ __forceinline__ void convert_experts(Frame& F, int rank, int nranks) {
    LAS float* scr = (LAS float*)(F.lds + F.wave * 16640);
    const int st = nranks * NWAVES; int it = rank * NWAVES + F.wave;
    if (it >= 3 * 8192) return;
    float ta[64], tb[64]; v2u oa[8], ob[8]; XItem xa = expert_item(F, it), xb = xa;
    xitem_load(xa, ta, F.lane);
    for (;;) {
        xb = expert_item(F, it + st); xitem_load(xb, tb, F.lane);
        xitem_pack(ta, scr, F.lane, oa);
        const XItem xs = xa;
        it += 2 * st; const bool ha = it < 3 * 8192;
        if (ha) { xa = expert_item(F, it); xitem_load(xa, ta, F.lane); }
        xitem_pack(tb, scr, F.lane, ob);
        xpair_store(xs, oa, ob, F.lane);
        if (!ha) break;
    }
}
__device__ __forceinline__ void p0b_fold(Frame& F, int it, LAS float* scr) {
    const int g = it >> 9, r = it & 511, k0 = (r >> 2) * 8, e = (r & 3) * 64 + F.lane;
    float acc[8];
#pragma unroll
    for (int kk = 0; kk < 8; ++kk) acc[kk] = 0.f;
    const float* wp = F.w_pool + (size_t)g * 65536 + e;
    const float* wi = F.w_in + (size_t)k0 * NPROJ + 3072 + g * 256;
#pragma unroll
    for (int kk = 0; kk < 8; ++kk) ((LAS f32x4*)scr)[kk * 64 + F.lane] = *(const f32x4*)(wi + (size_t)kk * NPROJ + 4 * F.lane);
    float p0[16], p1[16];
#pragma unroll
    for (int j = 0; j < 16; ++j) p0[j] = wp[j * 256];
    LDS_WAIT(); asm volatile("" ::: "memory");
#define FOLD_STEP(PC, PN, S, MORE) { if (MORE) { _Pragma("unroll") for (int j = 0; j < 16; ++j) PN[j] = wp[(((S) + 1) * 16 + j) * 256]; } \
        _Pragma("unroll") for (int j = 0; j < 16; j += 4) { asm volatile("" ::: "memory"); \
            _Pragma("unroll") for (int kk = 0; kk < 8; ++kk) { const f32x4 w = *(const LAS f32x4*)(scr + kk * 256 + (S) * 16 + j); \
                acc[kk] += (w[0] * PC[j] + w[1] * PC[j + 1]) + (w[2] * PC[j + 2] + w[3] * PC[j + 3]); } } }
#pragma clang loop unroll(disable)
    for (int s8 = 0; s8 < 16; s8 += 2) {
        FOLD_STEP(p0, p1, s8, true)
        FOLD_STEP(p1, p0, s8 + 1, s8 + 2 < 16)
    }
#undef FOLD_STEP
    LDS_WAIT(); asm volatile("" ::: "memory");
    const float ps = F.pool_scale[g * 256 + e];
    v4u o0;
    o0.x = pk2(acc[0] * ps, acc[1] * ps); o0.y = pk2(acc[2] * ps, acc[3] * ps); o0.z = pk2(acc[4] * ps, acc[5] * ps); o0.w = pk2(acc[6] * ps, acc[7] * ps);
    bf16* dst = (bf16*)(F.ws + WS_WIN) + (size_t)(4096 + g * 256 + e) * D + k0;
    *(GAS v4u*)dst = o0;
}
__device__ __forceinline__ void p0b_rw(Frame& F, int it) {
    const int ks = it / 5, j = it - ks * 5, col = 16 * j + (F.lane & 15), kb = 32 * ks + 8 * (F.lane >> 4);
    float v[8];
#pragma unroll
    for (int e = 0; e < 8; ++e) { const int k = kb + e; const float* src = col < 8 ? F.w_group + k * 8 + col : F.w_router + k * 64 + (col < 72 ? col - 8 : 0); const float t = *src; v[e] = col < 72 ? t : 0.f; }
    unsigned hi[4], lo[4];
#pragma unroll
    for (int i = 0; i < 4; ++i) { const unsigned h0 = f2bf(v[2 * i]), h1 = f2bf(v[2 * i + 1]); hi[i] = h0 | (h1 << 16);
        lo[i] = pk2(v[2 * i] - __builtin_bit_cast(float, h0 << 16), v[2 * i + 1] - __builtin_bit_cast(float, h1 << 16)); }
    v4u* rw = (v4u*)(F.ws + WS_RW);
    rw[(size_t)(it * 2 + 0) * 64 + F.lane] = (v4u){hi[0], hi[1], hi[2], hi[3]};
    rw[(size_t)(it * 2 + 1) * 64 + F.lane] = (v4u){lo[0], lo[1], lo[2], lo[3]};
}
__device__ __forceinline__ void p0b_prologue(Frame& F) {
    const int gw = blockIdx.x * NWAVES + F.wave, NGW = F.G * NWAVES;
    const float* modp = (const float*)(F.ws + WS_MODP);
    LAS float* scr = (LAS float*)(F.lds + F.wave * 16640);
    for (int it = gw; it < 2048; it += NGW) p0b_fold(F, it, scr);
    for (int it = NGW - 1 - gw; it < 160; it += NGW) p0b_rw(F, it);
    for (int gid = gw * 64 + F.lane; gid < NBATCH * NPROJ; gid += NGW * 64) { const int b = gid / NPROJ, j = gid - b * NPROJ;
        float s = F.b_ada[j];
#pragma unroll
        for (int kc = 0; kc < NKC; ++kc) s += modp[((size_t)kc * 4 + b) * NPROJ + j];
        ((float*)(F.ws + WS_MOD))[gid] = s;
        if (gid < NBATCH * D) { const int bb = gid >> 10, cc = gid & 1023; float s2 = F.b_ada[4096 + cc], sh2 = F.b_ada[3072 + cc];
#pragma unroll
            for (int kc = 0; kc < NKC; ++kc) { s2 += modp[((size_t)kc * 4 + bb) * NPROJ + 4096 + cc]; sh2 += modp[((size_t)kc * 4 + bb) * NPROJ + 3072 + cc]; }
            float* gcbc = (float*)(F.ws + WS_GCBC); gcbc[gid] = F.ln1_g[cc] * (1.0f + s2); gcbc[NBATCH * D + gid] = F.ln1_b[cc] * (1.0f + s2) + sh2; } }
    for (int it = gw; it < NT_ITEMS; it += NGW) p0b_transpose(F, it, scr);
    bf16* U = (bf16*)(F.ws + WS_U);
    for (int blk = blockIdx.x; blk < NBLK; blk += F.G) { const int b = blk >> 6;
        LAS f32x4* ml = (LAS f32x4*)F.lds;
        __syncthreads();
        { const int c4 = 4 * F.tid; f32x4 pv[NKC], acc = *(const f32x4*)(F.b_ada + c4);
#pragma unroll
          for (int kc = 0; kc < NKC; ++kc) pv[kc] = *(const f32x4*)(modp + ((size_t)kc * 4 + b) * NPROJ + c4);
#pragma unroll
          for (int kc = 0; kc < NKC; ++kc) acc += pv[kc];
          ml[F.tid] = F.tid >= 256 ? acc + 1.0f : acc; }
        __syncthreads();
        f32x4 s1[4], sh1[4];
#pragma unroll
        for (int j = 0; j < 4; ++j) { sh1[j] = ml[F.lane + 64 * j]; s1[j] = ml[256 + F.lane + 64 * j]; }
        for (int rr = 0; rr < 16; rr += 4) { const size_t row = (size_t)blk * 128 + F.wave * 16 + rr;
            const GAS f32x4* xr = (const GAS f32x4*)(F.x + row * D) + F.lane; GAS v2u* ur = (GAS v2u*)(U + row * D) + F.lane;
            f32x4 xv[4][4];
#pragma unroll
            for (int q = 0; q < 4; ++q)
#pragma unroll
                for (int j = 0; j < 4; ++j) xv[q][j] = __builtin_nontemporal_load(xr + q * 256 + 64 * j);
#pragma unroll
            for (int q = 0; q < 4; ++q)
#pragma unroll
                for (int j = 0; j < 4; ++j) { const f32x4 v = xv[q][j] * s1[j] + sh1[j]; ur[q * 256 + 64 * j] = (v2u){pk2(v[0], v[1]), pk2(v[2], v[3])}; } }
    }
}

__device__ __forceinline__ void unpack8(const v4u w, float (&f)[8]) { f[0] = bflo(w.x); f[1] = bfhi(w.x); f[2] = bflo(w.y); f[3] = bfhi(w.y); f[4] = bflo(w.z); f[5] = bfhi(w.z); f[6] = bflo(w.w); f[7] = bfhi(w.w); }
__device__ __forceinline__ v4u pack8f(const float (&f)[8]) { return (v4u){pk2(f[0], f[1]), pk2(f[2], f[3]), pk2(f[4], f[5]), pk2(f[6], f[7])}; }
__device__ __forceinline__ void conv_fixup2(Frame& F, int pm0, int pm1, int n) {
    bf16* A2 = (bf16*)F.out;
    const bf16* VH = (const bf16*)(F.ws + WS_RAW); const bf16* ABH = VH + 128 * 2 * 1024; const bf16* VT = VH + 2 * 128 * 2 * 1024;
    const int r = F.tid >> 8, ch0 = (F.tid & 255) * 4;
    const f32x4 w0 = *(const f32x4*)(F.conv_w + ch0), w1 = *(const f32x4*)(F.conv_w + 1024 + ch0), w2 = *(const f32x4*)(F.conv_w + 2048 + ch0);
    v2u vh0[2], vh1[2], ab[2], t0[2], t1[2];
#pragma unroll
    for (int i = 0; i < 2; ++i) { const int pm = i == 0 ? pm0 : pm1;
        vh0[i] = *(const GAS v2u*)(VH + (size_t)(pm * 2 + 0) * 1024 + ch0); vh1[i] = *(const GAS v2u*)(VH + (size_t)(pm * 2 + 1) * 1024 + ch0); ab[i] = *(const GAS v2u*)(ABH + (size_t)(pm * 2 + r) * 1024 + ch0);
        t0[i] = (v2u){0u, 0u}; t1[i] = (v2u){0u, 0u};
        if (((pm * 256) & (T - 1)) > 0) { t0[i] = *(const GAS v2u*)(VT + (size_t)((pm - 1) * 2 + 0) * 1024 + ch0); t1[i] = *(const GAS v2u*)(VT + (size_t)((pm - 1) * 2 + 1) * 1024 + ch0); } }
#pragma unroll
    for (int i = 0; i < 2; ++i) { if (i >= n) break; const int pm = i == 0 ? pm0 : pm1;
        const f32x4 V0 = (f32x4){bflo(vh0[i].x), bfhi(vh0[i].x), bflo(vh0[i].y), bfhi(vh0[i].y)}, V1 = (f32x4){bflo(vh1[i].x), bfhi(vh1[i].x), bflo(vh1[i].y), bfhi(vh1[i].y)};
        const f32x4 T0 = (f32x4){bflo(t0[i].x), bfhi(t0[i].x), bflo(t0[i].y), bfhi(t0[i].y)}, T1 = (f32x4){bflo(t1[i].x), bfhi(t1[i].x), bflo(t1[i].y), bfhi(t1[i].y)}, AB = (f32x4){bflo(ab[i].x), bfhi(ab[i].x), bflo(ab[i].y), bfhi(ab[i].y)};
        const f32x4 o = (r == 0 ? (w0 * T0 + w1 * T1 + w2 * V0) : (w0 * T1 + w1 * V0 + w2 * V1)) * AB;
        *(GAS v2u*)(A2 + (size_t)(pm * 256 + r) * D + ch0) = (v2u){pk2(o[0], o[1]), pk2(o[2], o[3])}; }
}

__device__ __forceinline__ void p4_route(Frame& F) {
    const float* z = F.out; const f32x2* statp = (const f32x2*)(F.ws + WS_STATP);
    const float* gcbc = (const float*)(F.ws + WS_GCBC); const v4u* rw = (const v4u*)(F.ws + WS_RW);
    unsigned char* H = F.ws + WS_H; int* wgcnt = (int*)(F.ws + WS_WGCNT); v4u* tokinfo = (v4u*)(F.ws + WS_TOKINFO);
    LAS int* hist = (LAS int*)(F.lds + LT_HIST);
    LAS float* lg = (LAS float*)(F.lds + F.wave * 5120);
    const int r = F.lane & 15, q = F.lane >> 4;
    for (int blk = blockIdx.x; blk < NBLK; blk += F.G) {
        if (F.tid < 64) hist[F.tid] = 0;
        __syncthreads();
        const int row = blk * 128 + F.wave * 16 + r, b = blk >> 6;
        float s = 0.f, qq = 0.f;
#pragma unroll
        for (int i = 0; i < 4; ++i) { const f32x2 p = statp[(size_t)row * 16 + q * 4 + i]; s += p.x; qq += p.y; }
        s += __shfl_xor(s, 16); s += __shfl_xor(s, 32); qq += __shfl_xor(qq, 16); qq += __shfl_xor(qq, 32);
        const float mean = s * (1.0f / D), rstd = 1.0f / sqrtf(qq * (1.0f / D) - mean * mean + LN_EPS);
        pg8::f32x4 acc[5];
#pragma unroll
        for (int j = 0; j < 5; ++j) acc[j] = (pg8::f32x4){0.f, 0.f, 0.f, 0.f};
        const float* zr = z + (size_t)(blk * 128 + F.wave * 16 + (r & 7)) * D + 8 * q + 4 * (r >> 3);
        LAS unsigned char* hst = F.lds + F.wave * 5120;
        LAS float* gcl = (LAS float*)(F.lds + 73728); LAS float* bcl = gcl + D;
        LAS unsigned char* bb = F.lds + 49152;
        for (int i = F.tid; i < D / 4; i += 512) { ((LAS f32x4*)gcl)[i] = ((const f32x4*)(gcbc + b * D))[i]; ((LAS f32x4*)bcl)[i] = ((const f32x4*)(gcbc + NBATCH * D + b * D))[i]; }
        LAS float* brl = (LAS float*)(F.lds + 81920);
        if (F.tid >= 256 && F.tid < 256 + 72) { const int t = F.tid - 256; brl[t] = t < 8 ? F.b_group[t] : F.b_router[t - 8]; }
        const v4u* rwl = rw + F.wave * 64 + F.lane;
        v4u br[4][2]; f32x4 zq[4][2];
#pragma unroll
        for (int k = 0; k < 4; ++k) { br[k][0] = rwl[(size_t)k * 640]; br[k][1] = F.wave < 2 ? rwl[(size_t)k * 640 + 512] : (v4u){0u, 0u, 0u, 0u}; }
#pragma unroll
        for (int k = 0; k < 4; ++k) { zq[k][0] = __builtin_nontemporal_load((const f32x4*)(zr + 32 * k)); zq[k][1] = __builtin_nontemporal_load((const f32x4*)(zr + 8 * D + 32 * k)); }
        { LAS v4u* d0 = (LAS v4u*)bb + F.wave * 64 + F.lane; d0[0] = br[0][0]; if (F.wave < 2) d0[512] = br[0][1]; }
        __syncthreads();
        for (int ks0 = 0; ks0 < 32; ks0 += 4)
#pragma unroll
        for (int u = 0; u < 4; ++u) { const int ks = ks0 + u;
            f32x4 z0, z1;
#pragma unroll
            for (int e = 0; e < 4; ++e) { z0[e] = pg8::dpp_fill<0x118>(zq[u][0][e], zq[u][1][e]); z1[e] = pg8::dpp_fill<0x108>(zq[u][1][e], zq[u][0][e]); }
            if (ks + 4 < 32) { zq[u][0] = __builtin_nontemporal_load((const f32x4*)(zr + 32 * (ks + 4))); zq[u][1] = __builtin_nontemporal_load((const f32x4*)(zr + 8 * D + 32 * (ks + 4))); }
            const f32x4 g0 = *(const LAS f32x4*)(gcl + 32 * ks + 8 * q), g1 = *(const LAS f32x4*)(gcl + 32 * ks + 8 * q + 4), b0 = *(const LAS f32x4*)(bcl + 32 * ks + 8 * q), b1 = *(const LAS f32x4*)(bcl + 32 * ks + 8 * q + 4);
            const f32x4 h0 = (z0 - mean) * rstd * g0 + b0, h1 = (z1 - mean) * rstd * g1 + b1;
            const float hv[8] = {h0[0], h0[1], h0[2], h0[3], h1[0], h1[1], h1[2], h1[3]};
            unsigned hi[4], lo[4];
#pragma unroll
            for (int i = 0; i < 4; ++i) { const unsigned a0 = f2bf(hv[2 * i]), a1 = f2bf(hv[2 * i + 1]); hi[i] = a0 | (a1 << 16);
                lo[i] = pk2(hv[2 * i] - __builtin_bit_cast(float, a0 << 16), hv[2 * i + 1] - __builtin_bit_cast(float, a1 << 16)); }
            const v4u hiv = (v4u){hi[0], hi[1], hi[2], hi[3]}, lov = (v4u){lo[0], lo[1], lo[2], lo[3]};
            *(LAS v2u*)(hst + r * 144 + u * 32 + q * 8) = (v2u){pg8::pk4_fp8(hv[0], hv[1], hv[2], hv[3]), pg8::pk4_fp8(hv[4], hv[5], hv[6], hv[7])};
            if (u == 3) {
#pragma unroll
                for (int j = 0; j < 2; ++j) { const int rw_ = 8 * j + (F.lane >> 3), c16 = F.lane & 7;
                    const v4u t = *(const LAS v4u*)(hst + rw_ * 144 + c16 * 16);
                    *(GAS v4u*)(H + (size_t)(blk * 128 + F.wave * 16 + rw_) * D + 32 * (ks - 3) + c16 * 16) = t; } }
            const pg8::bf16x8 Ah = __builtin_bit_cast(pg8::bf16x8, hiv), Al = __builtin_bit_cast(pg8::bf16x8, lov);
            const LAS v4u* bl = (const LAS v4u*)(bb + (ks & 1) * 10240) + F.lane;
#pragma unroll
            for (int j = 0; j < 5; ++j) { const pg8::bf16x8 Bh = __builtin_bit_cast(pg8::bf16x8, bl[(j * 2 + 0) * 64]), Bl = __builtin_bit_cast(pg8::bf16x8, bl[(j * 2 + 1) * 64]);
                acc[j] = __builtin_amdgcn_mfma_f32_16x16x32_bf16(Ah, Bh, acc[j], 0, 0, 0);
                acc[j] = __builtin_amdgcn_mfma_f32_16x16x32_bf16(Al, Bh, acc[j], 0, 0, 0);
                acc[j] = __builtin_amdgcn_mfma_f32_16x16x32_bf16(Ah, Bl, acc[j], 0, 0, 0); }
            if (ks + 1 < 32) { LAS v4u* d1 = (LAS v4u*)(bb + ((ks + 1) & 1) * 10240) + F.wave * 64 + F.lane; d1[0] = br[(u + 1) & 3][0]; if (F.wave < 2) d1[512] = br[(u + 1) & 3][1]; }
            if (ks + 4 < 32) { br[u][0] = rwl[(size_t)(ks + 4) * 640]; if (F.wave < 2) br[u][1] = rwl[(size_t)(ks + 4) * 640 + 512]; }
            __syncthreads();
        }
#pragma unroll
        for (int j = 0; j < 5; ++j)
#pragma unroll
            for (int g = 0; g < 4; ++g) lg[(4 * q + g) * 80 + 16 * j + r] = acc[j][g];
        __syncthreads();
        if (F.lane < 16) {
            const LAS float* L = lg + F.lane * 80; const int token = blk * 128 + F.wave * 16 + F.lane;
            float gl[8];
#pragma unroll
            for (int i = 0; i < 8; ++i) gl[i] = L[i] + brl[i];
            int g = 0; float gm = gl[0];
#pragma unroll
            for (int i = 1; i < 8; ++i) if (gl[i] > gm) { gm = gl[i]; g = i; }
            float gs = 0.f;
#pragma unroll
            for (int i = 0; i < 8; ++i) gs += __expf(gl[i] - gm);
            const float gp = 1.0f / gs;
            float el[8];
#pragma unroll
            for (int i = 0; i < 8; ++i) el[i] = L[8 + g * 8 + i] + brl[8 + g * 8 + i];
            int e1 = 0; float m1 = el[0];
#pragma unroll
            for (int i = 1; i < 8; ++i) if (el[i] > m1) { m1 = el[i]; e1 = i; }
            int e2 = -1; float m2 = -3.0e38f;
#pragma unroll
            for (int i = 0; i < 8; ++i) if (i != e1 && el[i] > m2) { m2 = el[i]; e2 = i; }
            if (e2 < 0) e2 = (e1 + 1) & 7;
            const float p = __expf(m2 - m1), w1 = gp / (1.0f + p), w2 = gp * p / (1.0f + p);
            const int E1 = g * 8 + e1, E2 = g * 8 + e2;
            const int r1 = atomicAdd((int*)(F.ldsg + LT_HIST) + E1, 1), r2 = atomicAdd((int*)(F.ldsg + LT_HIST) + E2, 1);
            tokinfo[token] = (v4u){(unsigned)(E1 | (r1 << 8)), (unsigned)(E2 | (r2 << 8)), __builtin_bit_cast(unsigned, w1), __builtin_bit_cast(unsigned, w2)};
        }
        __syncthreads();
        if (F.tid < 64) wgcnt[blk * 64 + F.tid] = hist[F.tid];
        __syncthreads();
    }
}

__device__ __forceinline__ void p5a_dispatch(Frame& F, bool copy) {
    const int* wgcnt = (const int*)(F.ws + WS_WGCNT); const v4u* tokinfo = (const v4u*)(F.ws + WS_TOKINFO);
    int* row_slot = (int*)(F.ws + WS_ROWSLOT); float* row_wt = (float*)(F.ws + WS_ROWWT);
    int* row_tok = (int*)(F.ws + WS_ROWTOK);
    LAS int* pad_start = (LAS int*)(F.lds + LT_PADSTART); LAS int* tile_e = (LAS int*)(F.lds + LT_TILEE);
    LAS int* tot = (LAS int*)(F.lds + LT_TOT); LAS int* base = (LAS int*)(F.lds + LT_BASE);
    LAS int* ae = (LAS int*)(F.lds + LT_AE); LAS int* psum = (LAS int*)(F.lds + LT_PSUM);
    const int e_ = F.tid & 63, part = F.tid >> 6;
    bool first = true;
    for (int blk = blockIdx.x; blk < NBLK || first; blk += F.G) {
        int sa = 0, sb = 0;
#pragma unroll
        for (int i = 0; i < 32; ++i) { const int wg = part * 32 + i; const int v = wgcnt[wg * 64 + e_]; sa += v; sb += wg < blk ? v : 0; }
        psum[part * 64 + e_] = sa; psum[512 + part * 64 + e_] = sb;
        __syncthreads();
        if (F.tid < 64) { int a = 0, bsum = 0;
#pragma unroll
            for (int p = 0; p < 8; ++p) { a += psum[p * 64 + F.tid]; bsum += psum[512 + p * 64 + F.tid]; }
            tot[F.tid] = a; base[F.tid] = bsum; }
        __syncthreads();
        if (first) {
            if (F.tid < 64) { const int cnt = tot[F.tid], nt_ = (cnt + 255) >> 8, sm = ((cnt & 255) != 0 && (cnt & 255) <= 128) ? 1 : 0;
                int incl = nt_, inf = nt_ - sm, ins = sm;
#pragma unroll
                for (int o = 1; o < 64; o <<= 1) { const int v = __shfl_up(incl, o), vf = __shfl_up(inf, o), vs = __shfl_up(ins, o); if (F.tid >= o) { incl += v; inf += vf; ins += vs; } }
                const int nfull = __shfl(inf, 63), st = incl - nt_; pad_start[F.tid] = st << 8;
                for (int k = 0; k < nt_ - sm; ++k) tile_e[inf - (nt_ - sm) + k] = (st + k) | (F.tid << 16);
                if (sm) tile_e[nfull + ins - 1] = (st + nt_ - 1) | (F.tid << 16);
                if (F.tid == 63) { pad_start[64] = incl << 8; pad_start[65] = incl; pad_start[66] = nfull; } }
            __syncthreads();
            if (!copy) return;
            for (int e = blockIdx.x; e < NE; e += F.G) { const int p0 = pad_start[e] + tot[e], p1 = pad_start[e + 1]; for (int p = p0 + F.tid; p < p1; p += 512) { row_slot[p] = -1; row_wt[p] = 0.f; row_tok[p] = 0; } }
            first = false;
        }
        if (blk < NBLK) {
            if (F.tid < 256) { const int token = blk * 128 + (F.tid >> 1), k = F.tid & 1; const v4u info = tokinfo[token]; const unsigned ek = k ? info.y : info.x;
                const int e = (int)(ek & 255u), rank = (int)(ek >> 8); const float wt = __builtin_bit_cast(float, k ? info.w : info.z);
                const int pos = pad_start[e] + base[e] + rank; row_slot[pos] = token * 2 + k; row_wt[pos] = wt; row_tok[pos] = token; }
            __syncthreads();

        }
        __syncthreads();
    }
}

constexpr int P7R = 4;
__device__ __forceinline__ void p7_final(Frame& F) {
    float* z = F.out; const f32x2* statp = (const f32x2*)(F.ws + WS_STATP); const bf16* O = (const bf16*)(F.ws + WS_O); const float* mod = (const float*)(F.ws + WS_MOD);
    { int t_ = threadIdx.x; asm volatile("" : "+v"(t_)); F.tid = t_; F.lane = t_ & 63; }
    { const int blk = blockIdx.x, b = blk >> 6;
        f32x4 g1[4], b1[4], gt[4];
#pragma unroll
        for (int j = 0; j < 4; ++j) { const int col = 4 * F.lane + 256 * j; g1[j] = *(const f32x4*)(F.ln1_g + col); b1[j] = *(const f32x4*)(F.ln1_b + col); gt[j] = *(const f32x4*)(mod + b * NPROJ + 5 * D + col) + 1.0f; }
        LAS f32x4* l2 = (LAS f32x4*)F.lds;
        __syncthreads();
        l2[F.tid] = F.tid < 256 ? ((const f32x4*)F.ln2_g)[F.tid] : ((const f32x4*)F.ln2_b)[F.tid - 256];
        __syncthreads();
        for (int rr = 0; rr < 16; rr += P7R) { const size_t row0 = (size_t)blk * 128 + F.wave * 16 + rr;
            f32x4 zv[P7R][4]; v2u oa[P7R][4], oc[P7R][4]; f32x2 p[P7R];
#pragma unroll
            for (int u = 0; u < P7R; ++u) { const size_t row = row0 + u;
                p[u] = (f32x2){0.f, 0.f}; if (F.lane < 16) p[u] = statp[row * 16 + F.lane];
                const GAS f32x4* zr = (const GAS f32x4*)(z + row * D) + F.lane;
                const GAS v2u* o1 = (const GAS v2u*)(O + (2 * row) * D) + F.lane; const GAS v2u* o2 = (const GAS v2u*)(O + (2 * row + 1) * D) + F.lane;
#pragma unroll
                for (int j = 0; j < 4; ++j) { zv[u][j] = __builtin_nontemporal_load(zr + 64 * j); oa[u][j] = __builtin_nontemporal_load(o1 + 64 * j); oc[u][j] = __builtin_nontemporal_load(o2 + 64 * j); } }
            float s[P7R];
#pragma unroll
            for (int u = 0; u < P7R; ++u) {
                const float mean = wave_sum(p[u].x) * (1.0f / D), rstd = 1.0f / sqrtf(wave_sum(p[u].y) * (1.0f / D) - mean * mean + LN_EPS);
                s[u] = 0.f;
#pragma unroll
                for (int j = 0; j < 4; ++j) { const v2u a = oa[u][j], c = oc[u][j];
                    const f32x4 y = (f32x4){bflo(a.x) + bflo(c.x), bfhi(a.x) + bfhi(c.x), bflo(a.y) + bflo(c.y), bfhi(a.y) + bfhi(c.y)};
                    const f32x4 x1 = (zv[u][j] - mean) * rstd * g1[j] + b1[j];
                    zv[u][j] = x1 * ALPHA + gt[j] * y; s[u] += (zv[u][j][0] + zv[u][j][1]) + (zv[u][j][2] + zv[u][j][3]); } }
#pragma unroll
            for (int u = 0; u < P7R; ++u) { const size_t row = row0 + u;
                const float mean2 = wave_sum(s[u]) * (1.0f / D); float s2 = 0.f;
#pragma unroll
                for (int j = 0; j < 4; ++j) { zv[u][j] = zv[u][j] - mean2; s2 += (zv[u][j][0] * zv[u][j][0] + zv[u][j][1] * zv[u][j][1]) + (zv[u][j][2] * zv[u][j][2] + zv[u][j][3] * zv[u][j][3]); }
                const float rstd2 = 1.0f / sqrtf(wave_sum(s2) * (1.0f / D) + LN_EPS);
                GAS f32x4* zw = (GAS f32x4*)(z + row * D) + F.lane;
#pragma unroll
                for (int j = 0; j < 4; ++j) __builtin_nontemporal_store(zv[u][j] * rstd2 * l2[F.lane + 64 * j] + l2[256 + F.lane + 64 * j], zw + 64 * j); }
        }
    }
}

__device__ __forceinline__ void fill_rs(Frame& F, int t, int vcu, int ntiles) {
    const int* row_slot = (const int*)(F.ws + WS_ROWSLOT); const float* row_wt = (const float*)(F.ws + WS_ROWWT); LAS v2u* rs = (LAS v2u*)(F.lds + LT_HIST);
    int sl[5]; float wv[5];
#pragma unroll
    for (int i = 0; i < 5; ++i) { const int L = i * F.G + vcu; const bool ok = L < ntiles * 4; const int row = (ok ? (((const LAS int*)(F.lds + LT_TILEE))[L >> 2] & 0xffff) : 0) * 256 + t; sl[i] = ok ? row_slot[row] : -1; wv[i] = ok ? row_wt[row] : 0.f; }
#pragma unroll
    for (int i = 0; i < 5; ++i) rs[i * 256 + t] = (v2u){(unsigned)sl[i], __builtin_bit_cast(unsigned, wv[i])};
}

struct Args { const float* in[21]; float* out; unsigned char* ws; int ph_lo, ph_hi; };
#ifndef MK_N_LAUNCHES
#define MK_N_LAUNCHES 1
#endif
constexpr int N_PHASES = 11;
static_assert(NBLK == 256, "P7 takes one row block per workgroup of the 256-workgroup grid");
#ifndef KNOB_ALIGN
#define KNOB_ALIGN true
#endif
__global__ void __launch_bounds__(NWAVES * 64, 2) fwd(Args args) {
    extern __shared__ __attribute__((aligned(16))) unsigned char lds[];
    Frame F;
    F.lds = (LAS unsigned char*)lds; F.ldsg = lds;
    F.tid = threadIdx.x; F.lane = F.tid & 63; F.wave = __builtin_amdgcn_readfirstlane(F.tid >> 6); F.G = gridDim.x;
    F.ws = args.ws; F.out = args.out; F.ctl = (gu32*)(args.ws + WS_CTL);
    F.x = args.in[0]; F.c = args.in[1]; F.w_ada = args.in[2]; F.b_ada = args.in[3]; F.w_in = args.in[4]; F.conv_w = args.in[5]; F.w_out_conv = args.in[6]; F.w_pool = args.in[7];
    F.pool_scale = args.in[8]; F.w_o = args.in[9]; F.ln1_g = args.in[10]; F.ln1_b = args.in[11]; F.w_group = args.in[12]; F.b_group = args.in[13]; F.w_router = args.in[14];
    F.b_router = args.in[15]; F.w_gate = args.in[16]; F.w_up = args.in[17]; F.w_down = args.in[18]; F.ln2_g = args.in[19]; F.ln2_b = args.in[20];
    for (int u = F.tid; u < (LDS_BYTES - MISC_OFF) / 4; u += NWAVES * 64) ((LAS unsigned*)(F.lds + MISC_OFF))[u] = 0u;
    __syncthreads();
    XcdBarrier bar; bar.bar = (unsigned*)(F.ctl + CW_BAR); bar.x = 0; bar.st = nullptr;
    if (args.ph_hi - args.ph_lo > 1) bar = xcd_barrier_post((unsigned*)(F.ctl + CW_BAR), (volatile LAS unsigned*)(F.lds + MISC_OFF) + 8);
    const int bx = blockIdx.x, vcu = (F.G % 8 == 0) ? (bx % 8) * (F.G / 8) + bx / 8 : bx;

    const int lo = args.ph_lo, hi = args.ph_hi;
#define IN(k) (lo <= (k) && (k) < hi)
#define SEAM(k) do { if (IN(k) && IN((k) + 1)) xcd_barrier(bar); } while (0)
    if (IN(0)) p0a_mod(F);
    SEAM(0);
    if (IN(1)) { for (int i = F.tid; i < 3 * 1024 / 4; i += 512) ((LAS f32x4*)(F.lds + LT_CONVW))[i] = ((const f32x4*)F.conv_w)[i];
      p0b_prologue(F); }
    SEAM(1);
    if (IN(2)) { pg8::Gemm g{(const bf16*)(F.ws + WS_U), (const bf16*)(F.ws + WS_WIN), M, NPROJ, D}; pg8::StaticOrder S; S.init(M, NPROJ, F.G, bx);
      pg8::EpiProj E{(bf16*)F.out, F.ws + WS_GA, (bf16*)(F.ws + WS_Q), F.ws + WS_GB, (bf16*)(F.ws + WS_RAW), (bf16*)(F.ws + WS_RAW) + 128 * 2 * 1024, (bf16*)(F.ws + WS_RAW) + 2 * 128 * 2 * 1024, (const LAS float*)(F.lds + LT_CONVW), (LAS float*)(F.lds + RING_BYTES)};
      if (!IN(1)) { for (int i = F.tid; i < 3 * 1024 / 4; i += 512) ((LAS f32x4*)(F.lds + LT_CONVW))[i] = ((const f32x4*)F.conv_w)[i]; }
      __syncthreads();
      const bool first = ((bx >> 3) & 1) != 0;
      if (first) { convert_experts(F, blockIdx.x, F.G); __syncthreads(); }
      pg8::gemm_phase<pg8::EpiProj, pg8::StaticOrder, KNOB_ALIGN, true>(F.lds + RING_OFF, g, S, E);
      if (!first) { __syncthreads(); convert_experts(F, blockIdx.x, F.G); } }
    SEAM(2);
    if (IN(4)) { pg8::Gemm g{(const bf16*)F.out, (const bf16*)(F.ws + WS_WOC), M, D, D};
      pg8::StaticOrder S; S.init(M, D, F.G, bx);
      pg8::EpiMerge E{F.ws + WS_GA, F.ws + WS_GB, (const bf16*)(F.ws + WS_Q), (bf16*)(F.ws + WS_MG)};
      { pg8::Unit u0, u1; const bool h0 = S.next(0, u0), h1 = S.next(1, u1); if (h0) conv_fixup2(F, u0.pm, h1 ? u1.pm : u0.pm, h1 ? 2 : 1);
        VM_WAIT(); __syncthreads(); }
      pg8::gemm_phase<pg8::EpiMerge, pg8::StaticOrder, KNOB_ALIGN, true>(F.lds + RING_OFF, g, S, E); }
    SEAM(4);
    if (IN(5)) { pg8::Gemm g{(const bf16*)(F.ws + WS_MG), (const bf16*)(F.ws + WS_WO), M, D, D}; pg8::StaticOrder S; S.init(M, D, F.G, bx);
      pg8::EpiZ E{F.x, F.out, (const float*)(F.ws + WS_MOD), (pg8::f32x2*)(F.ws + WS_STATP), ALPHA};
      pg8::gemm_phase<pg8::EpiZ, pg8::StaticOrder, KNOB_ALIGN, true>(F.lds + RING_OFF, g, S, E); }
    SEAM(5);
    if (IN(6)) p4_route(F);
    SEAM(6);
    if (IN(7)) p5a_dispatch(F, true);
    SEAM(7);
    if (IN(8)) { if (!IN(7)) p5a_dispatch(F, false);
      const int ntiles = ((LAS int*)(F.lds + LT_PADSTART))[65];
      pg8::Gemm g{(const bf16*)(F.ws + WS_H), (const bf16*)(F.ws + WS_WGU), CAP, 4 * 256, D / 2};
      pg8::MoeOrder S{F.G, vcu, ntiles * 4, ((LAS int*)(F.lds + LT_PADSTART))[66], (const LAS int*)(F.lds + LT_TILEE)};
      pg8::EpiGU E{F.ws + WS_ACT};
      LAS unsigned short* toks = (LAS unsigned short*)(F.lds + RING_BYTES);
      { const int* row_tok = (const int*)(F.ws + WS_ROWTOK);
        if (F.tid < 256) { int tk[5];
#pragma unroll
          for (int i = 0; i < 5; ++i) { const int L = i * F.G + vcu; tk[i] = L < ntiles * 4 ? row_tok[(((const LAS int*)(F.lds + LT_TILEE))[L >> 2] & 0xffff) * 256 + F.tid] : 0; }
#pragma unroll
          for (int i = 0; i < 5; ++i) toks[i * 256 + F.tid] = (unsigned short)tk[i]; }
        else fill_rs(F, F.tid - 256, vcu, ntiles);
        __syncthreads(); }
      pg8::gemm_phase<pg8::EpiGU, pg8::MoeOrder, KNOB_ALIGN, true, true, pg8::NoPost, true>(F.lds + RING_OFF, g, S, E, toks); }
    SEAM(8);
    if (IN(9)) { if (!IN(7)) p5a_dispatch(F, false);
      const int ntiles = ((LAS int*)(F.lds + LT_PADSTART))[65];
      pg8::Gemm g{(const bf16*)(F.ws + WS_ACT), (const bf16*)(F.ws + WS_WD), CAP, 4 * 256, DE / 2};
      pg8::MoeOrder S{F.G, vcu, ntiles * 4, ((LAS int*)(F.lds + LT_PADSTART))[66], (const LAS int*)(F.lds + LT_TILEE)};
      LAS v2u* rs = (LAS v2u*)(F.lds + LT_HIST);
      if (!IN(8) || !IN(7)) { if (F.tid < 256) fill_rs(F, F.tid, vcu, ntiles); __syncthreads(); }
      pg8::EpiDown E{(bf16*)(F.ws + WS_O), (const LAS pg8::u32x2*)rs};
      pg8::gemm_phase<pg8::EpiDown, pg8::MoeOrder, KNOB_ALIGN, true, false, pg8::NoPost, true>(F.lds + RING_OFF, g, S, E); }
    SEAM(9);
    if (IN(10)) p7_final(F);
#undef IN
#undef SEAM
}

extern "C" void kernel_launch(void* const* d_in, const int* in_sizes, int n_in, void* d_out, int out_size, void* d_ws, size_t ws_size, hipStream_t stream) {
    static int grid = 0;
    if (grid == 0) {
        if (n_in != 21 || in_sizes[0] != M * D || out_size != M * D || ws_size < WS_END) { fprintf(stderr, "kernel_launch: built for 21 inputs, x/out of %d floats, >= %zu bytes of workspace; got n_in %d, in0 %d, out %d, ws %zu; nothing launched\n", M * D, (size_t)WS_END, n_in, n_in > 0 ? in_sizes[0] : -1, out_size, ws_size); grid = -1; return; }
        int dev = 0, cus = 0, per_cu = 0;
        if (hipGetDevice(&dev) != hipSuccess || hipDeviceGetAttribute(&cus, hipDeviceAttributeMultiprocessorCount, dev) != hipSuccess) { fprintf(stderr, "kernel_launch: device query failed\n"); grid = -1; return; }
        if (hipFuncSetAttribute((const void*)fwd, hipFuncAttributeMaxDynamicSharedMemorySize, LDS_BYTES) != hipSuccess) { fprintf(stderr, "kernel_launch: hipFuncSetAttribute failed\n"); grid = -1; return; }
        if (hipOccupancyMaxActiveBlocksPerMultiprocessor(&per_cu, (const void*)fwd, NWAVES * 64, LDS_BYTES) != hipSuccess || per_cu < 1) fprintf(stderr, "kernel_launch: note: occupancy query reports %d workgroups per CU\n", per_cu);
        (void)hipGetLastError();
        if (cus < 256) { fprintf(stderr, "kernel_launch: built for 256 CUs (per-workgroup LDS tables hold <= 5 expert units), found %d\n", cus); grid = -1; return; }
        grid = 256;
    }
    if (grid < 0) return;
    if (hipMemsetAsync((char*)d_ws + WS_CTL, 0, CTL_ZERO_BYTES, stream) != hipSuccess) { fprintf(stderr, "kernel_launch: memset failed\n"); return; }
    Args a{};
    for (int i = 0; i < 21; ++i) a.in[i] = (const float*)d_in[i];
    a.out = (float*)d_out; a.ws = (unsigned char*)d_ws;
#if MK_N_LAUNCHES == 1
    a.ph_lo = 0; a.ph_hi = N_PHASES;
    hipLaunchKernelGGL(fwd, dim3(grid), dim3(NWAVES * 64), LDS_BYTES, stream, a);
#else
    for (int p = 0; p < N_PHASES; ++p) {
        a.ph_lo = p; a.ph_hi = p + 1; hipLaunchKernelGGL(fwd, dim3(grid), dim3(NWAVES * 64), LDS_BYTES, stream, a);
    }
#endif
    const hipError_t le = hipPeekAtLastError();
    if (le != hipSuccess) fprintf(stderr, "kernel_launch: launch failed: %s\n", hipGetErrorName(le));
}
```

```cpp
#define MK_N_LAUNCHES 1
#include <hip/hip_runtime.h>
#include <cstdio>
#include <cstdint>
namespace pg8 {
#define PG8_LAS __attribute__((address_space(3)))
typedef unsigned short bf16_t;
typedef short bf16x8 __attribute__((ext_vector_type(8)));
typedef float f32x4 __attribute__((ext_vector_type(4)));
typedef unsigned u32x4 __attribute__((ext_vector_type(4)));
constexpr int BM = 256, BK = 64, HALF = 128, HTB = HALF * BK * 2  , STAGE_BYTES = 8 * HTB, NXCD = 8, WGM = 8;

__host__ __device__ __forceinline__ int lds_byte(int r, int c) { const int st = (r >> 4) * 2 + (c >> 5), rr = r & 15, cc = c & 31, ob = rr * 64 + cc * 2; return st * 1024 + (ob ^ (((ob >> 9) & 1) << 5)); }
__host__ __device__ __forceinline__ void stage_rc(int b, int& R, int& C) { const int st = b / 1024, sb = b % 1024, swz = sb ^ (((sb >> 9) & 1) << 5); R = (st >> 1) * 16 + swz / 64; C = (st & 1) * 32 + (swz % 64) / 2; }
__host__ __device__ __forceinline__ int perm32(int rho) { const int n = rho >> 4, i = rho & 15; return 8 * (i >> 2) + 4 * n + (i & 3); }

struct Unit { int pm, pn, ord, hm; };
struct Gemm { const bf16_t* A; const bf16_t* Bt; int M, N, K; };

struct StaticOrder {
    int nM, nN, nwg, G, c;
    __host__ __device__ void init(int M, int N, int G_, int c_) { nM = M / BM; nN = N / BM; nwg = nM * nN; G = G_; c = c_; }
    __host__ __device__ bool next(int i, Unit& u) const {
        const long L = (long)i * G + c; if (L >= nwg) return false;
        int wgid = (int)L; { const int q = nwg / NXCD, r = nwg % NXCD, xcd = wgid % NXCD, off = wgid / NXCD; wgid = (xcd < r ? xcd * (q + 1) : r * (q + 1) + (xcd - r) * q) + off; }
        const int nig = WGM * nN, gid = wgid / nig, fm = gid * WGM, gsz = (nM - fm) < WGM ? (nM - fm) : WGM;
        u.pm = fm + ((wgid % nig) % gsz); u.pn = (wgid % nig) / gsz; u.ord = i; u.hm = 0; return true;
    }
    __device__ __forceinline__ void a_ready(const Unit&) const {}
    __device__ __forceinline__ void done(const Unit&) const {}
};
struct RangeOrder {
    StaticOrder S; int i0, n;
    __host__ __device__ bool next(int i, Unit& u) const { if (i >= n) return false; const bool ok = S.next(i0 + i, u); u.ord = i; return ok; }
    __device__ __forceinline__ void a_ready(const Unit&) const {}
    __device__ __forceinline__ void done(const Unit&) const {}
};
typedef __bf16 bf16v2_t __attribute__((ext_vector_type(2)));
typedef float f32x2 __attribute__((ext_vector_type(2)));
__device__ __forceinline__ unsigned cvt_pk_bf16(float lo, float hi) { const bf16v2_t r = __builtin_convertvector((f32x2){lo, hi}, bf16v2_t); return __builtin_bit_cast(unsigned, r); }

typedef unsigned u32x2 __attribute__((ext_vector_type(2)));
__device__ __forceinline__ float bf_lo(unsigned w) { return __builtin_bit_cast(float, w << 16); }
__device__ __forceinline__ float bf_hi(unsigned w) { return __builtin_bit_cast(float, w & 0xffff0000u); }
__device__ __forceinline__ float sigmoidf_(float x) { return __builtin_amdgcn_rcpf(1.0f + __expf(-x)); }
__device__ __forceinline__ u32x4 pack8(const f32x4 v0, const f32x4 v1) { u32x4 w; w.x = cvt_pk_bf16(v0[0], v0[1]); w.y = cvt_pk_bf16(v0[2], v0[3]); w.z = cvt_pk_bf16(v1[0], v1[1]); w.w = cvt_pk_bf16(v1[2], v1[3]); return w; }

__device__ __forceinline__ unsigned pk4_u8(float a, float b, float c, float d) { int r = 0; r = __builtin_amdgcn_cvt_pk_u8_f32(a * 255.0f, 0, r); r = __builtin_amdgcn_cvt_pk_u8_f32(b * 255.0f, 1, r); r = __builtin_amdgcn_cvt_pk_u8_f32(c * 255.0f, 2, r); r = __builtin_amdgcn_cvt_pk_u8_f32(d * 255.0f, 3, r); return (unsigned)r; }
__device__ __forceinline__ float u8f(unsigned w, int b) { return (float)((w >> (8 * b)) & 0xffu) * (1.0f / 255.0f); }
template <int CTRL> __device__ __forceinline__ float dpp_mov(float v) { return __builtin_bit_cast(float, __builtin_amdgcn_update_dpp(0, __builtin_bit_cast(int, v), CTRL, 0xF, 0xF, false)); }
template <int CTRL> __device__ __forceinline__ unsigned dpp_fillu(unsigned old, unsigned v) { return (unsigned)__builtin_amdgcn_update_dpp((int)old, (int)v, CTRL, 0xF, 0xF, false); }
template <int CTRL> __device__ __forceinline__ float dpp_fill(float old, float v) { return __builtin_bit_cast(float, __builtin_amdgcn_update_dpp(__builtin_bit_cast(int, old), __builtin_bit_cast(int, v), CTRL, 0xF, 0xF, false)); }
__device__ __forceinline__ size_t blk_index(int pm, int g, int wave, int ai, int bj, int m) { return (size_t)((((((pm * 4 + g) * 8 + wave) * 2 + ai) * 2 + bj) * 4 + m)); }
struct EpiProj {
    static constexpr bool PERM = true, AFTER_DRAIN = false;
    bf16_t *A2; unsigned char* GA; bf16_t* Q; unsigned char* GB; bf16_t *VH, *ABH, *VT; const PG8_LAS float* conv_w; PG8_LAS float* xb;
    __device__ __forceinline__ void operator()(const f32x4 (&acc)[2][2][4][2], const Unit& u, int wr, int wc, int fr, int fq) const {
        const int row0 = u.pm * BM + wr * 64 + fr, pn = u.pn;
        if (pn >= 16) {
            const int g = pn & 3, wave = wr * 4 + wc, lane8 = (fq * 16 + fr) * 8;
            if (pn < 20) {
#pragma unroll
                for (int ai = 0; ai < 2; ++ai)
#pragma unroll
                    for (int m = 0; m < 4; ++m)
#pragma unroll
                        for (int bj = 0; bj < 2; ++bj) *(u32x4*)(Q + blk_index(u.pm, g, wave, ai, bj, m) * 512 + lane8) = pack8(acc[ai][bj][m][0], acc[ai][bj][m][1]);
            } else {
#pragma unroll
                for (int ai = 0; ai < 2; ++ai)
#pragma unroll
                    for (int m = 0; m < 4; ++m)
#pragma unroll
                        for (int bj = 0; bj < 2; ++bj) { f32x4 v0 = acc[ai][bj][m][0], v1 = acc[ai][bj][m][1];
#pragma unroll
                            for (int j = 0; j < 4; ++j) { v0[j] = sigmoidf_(v0[j]); v1[j] = sigmoidf_(v1[j]); }
                            *(u32x2*)(GB + blk_index(u.pm, g, wave, ai, bj, m) * 512 + lane8) = (u32x2){pk4_u8(v0[0], v0[1], v0[2], v0[3]), pk4_u8(v1[0], v1[1], v1[2], v1[3])}; }
            }
            return;
        }
        const int ch0 = pn * 64 + wc * 16 + 4 * fq;
        const f32x4 w0 = *(const PG8_LAS f32x4*)(conv_w + ch0), w1 = *(const PG8_LAS f32x4*)(conv_w + 1024 + ch0), w2 = *(const PG8_LAS f32x4*)(conv_w + 2048 + ch0);
#pragma unroll
        for (int ai = 0; ai < 2; ++ai) { const f32x4 vt = acc[ai][0][3][0] * acc[ai][0][3][1];
            if (fr >= 14) { *(PG8_LAS f32x4*)(xb + ((wc * 4 + 2 * ai + wr) * 2 + (fr - 14)) * 16 + 4 * fq) = vt;
                if (ai == 1 && wr == 1) *(u32x2*)(VT + (size_t)(u.pm * 2 + (fr - 14)) * 1024 + ch0) = (u32x2){cvt_pk_bf16(vt[0], vt[1]), cvt_pk_bf16(vt[2], vt[3])}; } }
        asm volatile("s_waitcnt lgkmcnt(0)" ::: "memory"); __builtin_amdgcn_s_barrier(); asm volatile("" ::: "memory");
#pragma unroll
        for (int ai = 0; ai < 2; ++ai) { const int q = 2 * ai + wr;
            f32x4 t14 = (f32x4){0.f, 0.f, 0.f, 0.f}, t15 = t14, vprev = t14;
            if (q > 0) { t14 = *(const PG8_LAS f32x4*)(xb + ((wc * 4 + q - 1) * 2 + 0) * 16 + 4 * fq); t15 = *(const PG8_LAS f32x4*)(xb + ((wc * 4 + q - 1) * 2 + 1) * 16 + 4 * fq); }
            u32x2 a2w[4]; unsigned gaw[4];
#pragma unroll
            for (int m = 0; m < 4; ++m) { const f32x4 V = acc[ai][0][m][0] * acc[ai][0][m][1], ab = acc[ai][1][m][0]; f32x4 o, ga;
#pragma unroll
                for (int e = 0; e < 4; ++e) { float p1, p2;
                    if (m == 0) { p1 = t15[e]; p2 = fr == 1 ? t15[e] : t14[e]; } else { p1 = dpp_mov<0x10F>(vprev[e]); p2 = dpp_mov<0x10E>(vprev[e]); }
                    const float vm1 = dpp_fill<0x111>(p1, V[e]), vm2 = dpp_fill<0x112>(p2, V[e]);
                    o[e] = (w0[e] * vm2 + w1[e] * vm1 + w2[e] * V[e]) * ab[e]; ga[e] = sigmoidf_(acc[ai][1][m][1][e]); }
                if (q == 0 && m == 0 && fr < 2) { *(u32x2*)(VH + (size_t)(u.pm * 2 + fr) * 1024 + ch0) = (u32x2){cvt_pk_bf16(V[0], V[1]), cvt_pk_bf16(V[2], V[3])};
                    *(u32x2*)(ABH + (size_t)(u.pm * 2 + fr) * 1024 + ch0) = (u32x2){cvt_pk_bf16(ab[0], ab[1]), cvt_pk_bf16(ab[2], ab[3])}; }
                a2w[m] = (u32x2){cvt_pk_bf16(o[0], o[1]), cvt_pk_bf16(o[2], o[3])}; gaw[m] = pk4_u8(ga[0], ga[1], ga[2], ga[3]);
                vprev = V; }
            const bool odd = (fq & 1) != 0; const int chs = pn * 64 + wc * 16 + 4 * (fq & ~1);
#pragma unroll
            for (int mp = 0; mp < 2; ++mp) { const int m0 = 2 * mp, m1 = m0 + 1;
                const u32x2 sa = odd ? a2w[m0] : a2w[m1]; const unsigned sg = odd ? gaw[m0] : gaw[m1];
                u32x2 ra; ra.x = __shfl_xor(sa.x, 16); ra.y = __shfl_xor(sa.y, 16); const unsigned rg = __shfl_xor(sg, 16);
                const int mm = odd ? m1 : m0; const size_t off = (size_t)(row0 + ai * HALF + mm * 16) * 1024 + chs;
                const u32x4 wa = odd ? (u32x4){ra.x, ra.y, a2w[m1].x, a2w[m1].y} : (u32x4){a2w[m0].x, a2w[m0].y, ra.x, ra.y};
                const u32x2 wg = odd ? (u32x2){rg, gaw[m1]} : (u32x2){gaw[m0], rg};
                if (!(q == 0 && mm == 0 && fr < 2)) *(u32x4*)(A2 + off) = wa;
                *(u32x2*)(GA + blk_index(u.pm, pn >> 2, wr * 4 + 2 * (pn & 1) + (wc >> 1), ai, (pn & 3) >> 1, mm) * 512 + ((2 * (wc & 1) + (fq >> 1)) * 16 + fr) * 8) = wg; } }
    }
};
__device__ __forceinline__ float scan_pre(float x) { x += dpp_mov<0x111>(x); x += dpp_mov<0x112>(x); x += dpp_mov<0x114>(x); x += dpp_mov<0x118>(x); return x; }
__device__ __forceinline__ float scan_suf(float x) { x += dpp_mov<0x101>(x); x += dpp_mov<0x102>(x); x += dpp_mov<0x104>(x); x += dpp_mov<0x108>(x); return x; }
template <int W> __device__ __forceinline__ float pool_sum(float pre, float sufprev) { float t1 = 0.f; if constexpr (W < 16) t1 = dpp_mov<0x110 + W>(pre); return pre - t1 + dpp_mov<0x100 + (17 - W)>(sufprev); }
struct EpiMerge {
    static constexpr bool PERM = true, AFTER_DRAIN = false;
    const unsigned char* GA; const unsigned char* GB; const bf16_t* Q; bf16_t* MG;
    template <int W> __device__ __forceinline__ void tile(const f32x4 (&acc)[2][2][4][2], const Unit& u, int wr, int wc, int fr, int fq) const {
        const int rb = u.pm * BM + wr * 64; int col0 = u.pn * BM + wc * 32 + 8 * fq;
        asm volatile("" : "+v"(col0));
        u32x4 qv[2][4], qp[2]; u32x2 ga[2][4], gb[2][4];
        const int wave_ = wr * 4 + wc, lane8_ = (fq * 16 + fr) * 8;
#define MG_LOAD(K) { const int ai_ = (K) >> 1, bj_ = (K) & 1, rblk_ = rb + ai_ * HALF; const size_t o_ = (size_t)(rblk_ + fr) * 1024 + col0 + bj_ * HALF; \
        _Pragma("unroll") for (int m = 0; m < 4; ++m) { const size_t b_ = blk_index(u.pm, u.pn, wave_, ai_, bj_, m) * 512 + lane8_; \
            qv[(K) & 1][m] = __builtin_nontemporal_load((const u32x4*)(Q + b_)); ga[(K) & 1][m] = __builtin_nontemporal_load((const u32x2*)(GA + b_)); gb[(K) & 1][m] = __builtin_nontemporal_load((const u32x2*)(GB + b_)); } \
        qp[(K) & 1] = (u32x4){0u, 0u, 0u, 0u}; \
        if ((rblk_ & 8191) != 0) qp[(K) & 1] = *(const u32x4*)(Q + blk_index(wr == 0 && ai_ == 0 ? u.pm - 1 : u.pm, u.pn, wr == 1 ? wc : 4 + wc, wr == 1 ? ai_ : 1 - ai_, bj_, 3) * 512 + lane8_); }
        MG_LOAD(0)
#pragma unroll
        for (int k = 0; k < 4; ++k) { const int ai = k >> 1, bj = k & 1, rblk = rb + ai * HALF;
            const size_t off0 = (size_t)(rblk + fr) * 1024 + col0 + bj * HALF;
            if (k < 3) MG_LOAD(k + 1)
            const u32x4 pp = qp[k & 1]; float sp[8];
            sp[0] = scan_suf(bf_lo(pp.x)); sp[1] = scan_suf(bf_hi(pp.x)); sp[2] = scan_suf(bf_lo(pp.y)); sp[3] = scan_suf(bf_hi(pp.y));
            sp[4] = scan_suf(bf_lo(pp.z)); sp[5] = scan_suf(bf_hi(pp.z)); sp[6] = scan_suf(bf_lo(pp.w)); sp[7] = scan_suf(bf_hi(pp.w));
#pragma unroll
            for (int m = 0; m < 4; ++m) { const int ts = (rblk + m * 16 + fr) & 8191;
                const float inv = (ts + 1 < W) ? __builtin_amdgcn_rcpf((float)(ts + 1)) : (1.0f / W);
                const u32x4 qq = qv[k & 1][m]; const u32x2 g_a = ga[k & 1][m], g_b = gb[k & 1][m]; float x[8];
                x[0] = bf_lo(qq.x); x[1] = bf_hi(qq.x); x[2] = bf_lo(qq.y); x[3] = bf_hi(qq.y); x[4] = bf_lo(qq.z); x[5] = bf_hi(qq.z); x[6] = bf_lo(qq.w); x[7] = bf_hi(qq.w);
                f32x4 v0, v1;
#pragma unroll
                for (int e = 0; e < 4; ++e) {
                    const float p0 = pool_sum<W>(scan_pre(x[e]), sp[e]) * inv - x[e], p1 = pool_sum<W>(scan_pre(x[4 + e]), sp[4 + e]) * inv - x[4 + e];
                    sp[e] = scan_suf(x[e]); sp[4 + e] = scan_suf(x[4 + e]);
                    v0[e] = u8f(g_a.x, e) * acc[ai][bj][m][0][e] + u8f(g_b.x, e) * p0; v1[e] = u8f(g_a.y, e) * acc[ai][bj][m][1][e] + u8f(g_b.y, e) * p1; }
                *(u32x4*)(MG + off0 + m * 16384) = pack8(v0, v1); }
            asm volatile("" ::: "memory"); }
#undef MG_LOAD
    }
    __device__ __forceinline__ void operator()(const f32x4 (&acc)[2][2][4][2], const Unit& u, int wr, int wc, int fr, int fq) const {
        if (u.pn == 0) tile<2>(acc, u, wr, wc, fr, fq); else if (u.pn == 1) tile<4>(acc, u, wr, wc, fr, fq); else if (u.pn == 2) tile<8>(acc, u, wr, wc, fr, fq); else tile<16>(acc, u, wr, wc, fr, fq);
    }
};
struct EpiZ {
    static constexpr bool PERM = false, AFTER_DRAIN = false;
    const float* x; float* z; const float* mod; f32x2* statp; float alpha;
    __device__ __forceinline__ void operator()(const f32x4 (&acc)[2][2][4][2], const Unit& u, int wr, int wc, int fr, int fq) const {
        const int row0 = u.pm * BM + wr * 64 + fr, b = (u.pm * BM) >> 13; int col0 = u.pn * BM + wc * 32 + 4 * fq;
        asm volatile("" : "+v"(col0));
        f32x4 gv[2][2];
#pragma unroll
        for (int bj = 0; bj < 2; ++bj)
#pragma unroll
            for (int n = 0; n < 2; ++n) gv[bj][n] = *(const f32x4*)(mod + b * 6144 + 2048 + col0 + bj * HALF + n * 16) + 1.0f;
        const int rowb = u.pm * BM + wr * 64, rsub = fr & 7, colx = col0 + 16 * (fr >> 3);
        f32x4 xl[3][2], xh[3][2];
#define Z_LOAD(K) { const size_t off_ = (size_t)(rowb + ((K) >> 2) * HALF + ((K) & 3) * 16 + rsub) * 1024 + colx; \
        _Pragma("unroll") for (int bj = 0; bj < 2; ++bj) { xl[(K) % 3][bj] = *(const f32x4*)(x + off_ + bj * HALF); xh[(K) % 3][bj] = *(const f32x4*)(x + off_ + 8 * 1024 + bj * HALF); } }
        Z_LOAD(0) Z_LOAD(1)
#pragma unroll
        for (int k = 0; k < 8; ++k) { const int ai = k >> 2, m = k & 3, row = row0 + ai * HALF + m * 16; const size_t off = (size_t)(rowb + ai * HALF + m * 16 + rsub) * 1024 + colx; float s = 0.f, q = 0.f;
            if (k < 6) Z_LOAD(k + 2)
#pragma unroll
            for (int bj = 0; bj < 2; ++bj) { const f32x4 XL = xl[k % 3][bj], XH = xh[k % 3][bj]; f32x4 x0, x1, ZL, ZH;
#pragma unroll
                for (int e = 0; e < 4; ++e) { x0[e] = dpp_fill<0x118>(XL[e], XH[e]); x1[e] = dpp_fill<0x108>(XH[e], XL[e]); }
                const f32x4 z0 = x0 * alpha + gv[bj][0] * acc[ai][bj][m][0], z1 = x1 * alpha + gv[bj][1] * acc[ai][bj][m][1];
                s += ((z0[0] + z0[1]) + (z0[2] + z0[3])) + ((z1[0] + z1[1]) + (z1[2] + z1[3]));
                q += ((z0[0] * z0[0] + z0[1] * z0[1]) + (z0[2] * z0[2] + z0[3] * z0[3])) + ((z1[0] * z1[0] + z1[1] * z1[1]) + (z1[2] * z1[2] + z1[3] * z1[3]));
#pragma unroll
                for (int e = 0; e < 4; ++e) { ZL[e] = dpp_fill<0x118>(z0[e], z1[e]); ZH[e] = dpp_fill<0x108>(z1[e], z0[e]); }
                *(f32x4*)(z + off + bj * HALF) = ZL; *(f32x4*)(z + off + 8 * 1024 + bj * HALF) = ZH; }
            s += __shfl_xor(s, 16); s += __shfl_xor(s, 32); q += __shfl_xor(q, 16); q += __shfl_xor(q, 32);
            if (fq == 0) statp[(size_t)row * 16 + u.pn * 4 + wc] = (f32x2){s, q};
            asm volatile("" ::: "memory"); }
#undef Z_LOAD
    }
};
__device__ __forceinline__ unsigned pk4_fp8(float a, float b, float c, float d) { int r = 0; r = __builtin_amdgcn_cvt_pk_fp8_f32(a, b, r, false); r = __builtin_amdgcn_cvt_pk_fp8_f32(c, d, r, true); return (unsigned)r; }
constexpr float W8_SCALE = 64.0f, ACT8_SCALE = 8.0f;
struct EpiGU {
    static constexpr bool PERM = true, AFTER_DRAIN = false;
    unsigned char* ACT;
    __device__ __forceinline__ void operator()(const f32x4 (&acc)[2][2][4][2], const Unit& u, int wr, int wc, int fr, int fq) const {
        const int row0 = u.pm * BM + wr * 64 + fr, col0 = (u.pn & 3) * 128 + wc * 32 + 8 * fq;
        const float is = 1.0f / W8_SCALE, os = ACT8_SCALE / W8_SCALE;
#pragma unroll
        for (int ai = 0; ai < 2; ++ai) { if (ai == 1 && u.hm) break;
#pragma unroll
            for (int m = 0; m < 4; ++m) { unsigned char* rowp = ACT + (size_t)(row0 + ai * HALF + m * 16) * 512 + col0; f32x4 v0, v1;
#pragma unroll
                for (int j = 0; j < 4; ++j) { const float g0 = acc[ai][0][m][0][j] * is, g1 = acc[ai][0][m][1][j] * is;
                    v0[j] = __builtin_fminf(__builtin_fmaxf(g0 * sigmoidf_(g0) * acc[ai][1][m][0][j] * os, -448.0f), 448.0f); v1[j] = __builtin_fminf(__builtin_fmaxf(g1 * sigmoidf_(g1) * acc[ai][1][m][1][j] * os, -448.0f), 448.0f); }
                *(u32x2*)rowp = (u32x2){pk4_fp8(v0[0], v0[1], v0[2], v0[3]), pk4_fp8(v1[0], v1[1], v1[2], v1[3])}; } }
    }
};
constexpr float O8_SCALE = 16.0f;
struct EpiDown {
    static constexpr bool PERM = true, AFTER_DRAIN = false;
    unsigned char* O; const PG8_LAS u32x2* rs;
    __device__ __forceinline__ void operator()(const f32x4 (&acc)[2][2][4][2], const Unit& u, int wr, int wc, int fr, int fq) const {
        asm volatile("" : "+v"(fr), "+v"(fq));
        const int colx = (u.pn & 3) * 256 + wc * 64 + 32 * (fr >> 3) + 8 * fq;
        const PG8_LAS unsigned* tb = (const PG8_LAS unsigned*)(rs + u.ord * 256 + wr * 64);
#pragma unroll
        for (int ai = 0; ai < 2; ++ai) { if (ai == 1 && u.hm) break;
#pragma unroll
            for (int m = 0; m < 4; ++m) { const int rb = ai * HALF + m * 16;
                const float wt = __builtin_bit_cast(float, tb[(rb + fr) * 2 + 1]) * (O8_SCALE / (W8_SCALE * ACT8_SCALE));
                const int slo = (int)tb[(rb + (fr & 7)) * 2], shi = (int)tb[(rb + 8 + (fr & 7)) * 2];
                u32x2 pk[2];
#pragma unroll
                for (int bj = 0; bj < 2; ++bj) { f32x4 v0 = acc[ai][bj][m][0] * wt, v1 = acc[ai][bj][m][1] * wt;
#pragma unroll
                    for (int e = 0; e < 4; ++e) { v0[e] = __builtin_fminf(__builtin_fmaxf(v0[e], -448.0f), 448.0f); v1[e] = __builtin_fminf(__builtin_fmaxf(v1[e], -448.0f), 448.0f); }
                    pk[bj] = (u32x2){pk4_fp8(v0[0], v0[1], v0[2], v0[3]), pk4_fp8(v1[0], v1[1], v1[2], v1[3])}; }
                u32x2 sl, sh;
                sl.x = dpp_fillu<0x118>(pk[0].x, pk[1].x); sl.y = dpp_fillu<0x118>(pk[0].y, pk[1].y);
                sh.x = dpp_fillu<0x108>(pk[1].x, pk[0].x); sh.y = dpp_fillu<0x108>(pk[1].y, pk[0].y);
                if (slo >= 0) *(u32x2*)(O + (size_t)slo * 1024 + colx) = sl;
                if (shi >= 0) *(u32x2*)(O + (size_t)shi * 1024 + colx) = sh; } }
    }
};
struct MoeOrder {
    int G, vc, nunits, nfull; const PG8_LAS int* tinfo;
    __device__ __forceinline__ bool next(int i, Unit& u) const { const int L = i * G + vc; if (L >= nunits) return false; const int k = L >> 2, ti = tinfo[k];
        u.pm = ti & 0xffff; u.pn = (ti >> 16) * 4 + (L & 3); u.ord = i; u.hm = k >= nfull ? 1 : 0; return true; }
    __device__ __forceinline__ void a_ready(const Unit&) const {}
    __device__ __forceinline__ void done(const Unit&) const {}
};

struct NoPost { __device__ __forceinline__ void operator()(int) const {} };
typedef int i32x8 __attribute__((ext_vector_type(8))); typedef int i32x4 __attribute__((ext_vector_type(4)));
template <class Epi, class Sched, bool ALIGN_EPI = false, bool SP2 = false, bool GATHER = false, class Post = NoPost, bool FP8 = false>
__device__ __forceinline__ void gemm_phase(PG8_LAS unsigned char* lds, const Gemm g, const Sched& S, const Epi& E, const PG8_LAS unsigned short* toks = nullptr, const Post& PP = Post()) {
    static_assert(!GATHER || SP2, "gather is written for the SP2 loop only");
    int tid = threadIdx.x; asm volatile("" : "+v"(tid));
    const int wid = __builtin_amdgcn_readfirstlane(tid >> 6), lane = tid & 63, wr = wid >> 2, wc = wid & 3, fr = lane & 15, fq = lane >> 4;
    const int K = g.K, nt = K / BK;
    unsigned voffA[2], voffB[2];
#pragma unroll
    for (int i = 0; i < 2; ++i) { int R, C; stage_rc(tid * 16 + i * 8192, R, C); const int Rb = Epi::PERM ? ((R & ~31) + perm32(R & 31)) : R;
        voffA[i] = (unsigned)(R * K + C) * 2u; voffB[i] = (unsigned)(Rb * K + C) * 2u; }
    const size_t kstep = (size_t)(BK * 2);
    const size_t hstep = (size_t)HALF * K * 2;
    const size_t tstep = 2 * hstep;
    const unsigned ldsw = (unsigned)wid * 1024u;
    const int aoff = lds_byte(wr * 64 + fr, fq * 8), boff = lds_byte(wc * 32 + fr, fq * 8);
#define PG8_SA(b, h) (((b) * 2 + (h)) * HTB)
#define PG8_SB(b, h) ((4 + (b) * 2 + (h)) * HTB)
    const __amdgpu_buffer_rsrc_t rsA = __builtin_amdgcn_make_buffer_rsrc((void*)g.A, 0, (int)0xFFFFFFF0u, 0x00020000), rsB = __builtin_amdgcn_make_buffer_rsrc((void*)g.Bt, 0, (int)0xFFFFFFF0u, 0x00020000);
#define PG8_STAGE_X(rs, base, bufoff, gbase, voff) do { const unsigned _so = (unsigned)((const char*)(gbase) - (const char*)(base)); _Pragma("unroll") for (int _i = 0; _i < 2; ++_i) \
        __builtin_amdgcn_raw_ptr_buffer_load_lds(rs, (PG8_LAS unsigned*)(lds + (bufoff) + ldsw + _i * 8192), 16, (voff)[_i], _so, 0, 0); } while (0)
#define PG8_STAGE_A(bufoff, gbase) PG8_STAGE_X(rsA, g.A, bufoff, gbase, voffA)
#define PG8_STAGE_B(bufoff, gbase) PG8_STAGE_X(rsB, g.Bt, bufoff, gbase, voffB)
    unsigned vAc[2][2];
#define PG8_TOKL(j, h, _i) ({ int _R2, _C2; stage_rc(tid * 16 + (_i) * 8192, _R2, _C2); (unsigned)toks[(j) * BM + (h) * HALF + _R2] * (unsigned)(K * 2) + (unsigned)(_C2 * 2); })
#define PG8_STAGE_G(bufoff, kb, v, h) do { _Pragma("unroll") for (int _i = 0; _i < 2; ++_i) \
        __builtin_amdgcn_raw_ptr_buffer_load_lds(rsA, (PG8_LAS unsigned*)(lds + (bufoff) + ldsw + _i * 8192), 16, (v)[h][_i], (unsigned)(kb), 0, 0); } while (0)
#define PG8_STAGE_G2(bufoff, kb, h) do { _Pragma("unroll") for (int _i = 0; _i < 2; ++_i) { unsigned _o = vAc[h][_i]; if (last) _o = PG8_TOKL(has_next ? ui + 1 : ui, h, _i); \
        __builtin_amdgcn_raw_ptr_buffer_load_lds(rsA, (PG8_LAS unsigned*)(lds + (bufoff) + ldsw + _i * 8192), 16, _o, (unsigned)(kb), 0, 0); } } while (0)
#define PG8_LDA(dst, b, h) do { if constexpr (FP8) { _Pragma("unroll") for (int m = 0; m < 4; ++m) { const i32x4 _lo = *(const PG8_LAS i32x4*)(lds + PG8_SA(b, h) + aoff + m * 2048), _hi = *(const PG8_LAS i32x4*)(lds + PG8_SA(b, h) + aoff + m * 2048 + 1024); \
            dst##8[m] = __builtin_shufflevector(_lo, _hi, 0, 1, 2, 3, 4, 5, 6, 7); } } \
        else { _Pragma("unroll") for (int m = 0; m < 4; ++m) _Pragma("unroll") for (int k = 0; k < 2; ++k) dst[m][k] = *(const PG8_LAS bf16x8*)(lds + PG8_SA(b, h) + aoff + m * 2048 + k * 1024); } } while (0)
#define PG8_LDB(dst, b, h) do { if constexpr (FP8) { _Pragma("unroll") for (int n = 0; n < 2; ++n) { const i32x4 _lo = *(const PG8_LAS i32x4*)(lds + PG8_SB(b, h) + boff + n * 2048), _hi = *(const PG8_LAS i32x4*)(lds + PG8_SB(b, h) + boff + n * 2048 + 1024); \
            dst##8[n] = __builtin_shufflevector(_lo, _hi, 0, 1, 2, 3, 4, 5, 6, 7); } } \
        else { _Pragma("unroll") for (int n = 0; n < 2; ++n) _Pragma("unroll") for (int k = 0; k < 2; ++k) dst[n][k] = *(const PG8_LAS bf16x8*)(lds + PG8_SB(b, h) + boff + n * 2048 + k * 1024); } } while (0)
#define PG8_MMA(ai, bj, At, Bt) do { __builtin_amdgcn_s_setprio(1); \
        if constexpr (FP8) { _Pragma("unroll") for (int m = 0; m < 4; ++m) _Pragma("unroll") for (int n = 0; n < 2; ++n) \
            acc[ai][bj][m][n] = __builtin_amdgcn_mfma_scale_f32_16x16x128_f8f6f4(Bt##8[n], At##8[m], acc[ai][bj][m][n], 0, 0, 0, 0, 0, 0); } \
        else { _Pragma("unroll") for (int m = 0; m < 4; ++m) _Pragma("unroll") for (int n = 0; n < 2; ++n) _Pragma("unroll") for (int k = 0; k < 2; ++k) \
            acc[ai][bj][m][n] = __builtin_amdgcn_mfma_f32_16x16x32_bf16(Bt[n][k], At[m][k], acc[ai][bj][m][n], 0, 0, 0); } \
        __builtin_amdgcn_s_setprio(0); } while (0)
#define PG8_WAIT_V(n) asm volatile("s_waitcnt vmcnt(" #n ")" ::: "memory")
#define PG8_WAIT_L(n) asm volatile("s_waitcnt lgkmcnt(" #n ")" ::: "memory")
#define PG8_BAR __builtin_amdgcn_s_barrier()
#define PG8_SCHED __builtin_amdgcn_sched_barrier(0)
    Unit cur, nxt; int ui = 0;
    if (!S.next(0, cur)) return;
    f32x4 acc[2][2][4][2];
#pragma unroll
    for (int a = 0; a < 2; ++a)
#pragma unroll
        for (int b = 0; b < 2; ++b)
#pragma unroll
            for (int m = 0; m < 4; ++m)
#pragma unroll
                for (int n = 0; n < 2; ++n) acc[a][b][m][n] = (f32x4){0.f, 0.f, 0.f, 0.f};
    bf16x8 At[4][2], B0[2][2], B1[2][2]; i32x8 At8[4], B08[2], B18[2];
    const char* cA = (const char*)g.A + (size_t)cur.pm * tstep; const char* cB = (const char*)g.Bt + (size_t)cur.pn * tstep;
    S.a_ready(cur);
    if constexpr (SP2) {
        if constexpr (GATHER) {
#pragma unroll
            for (int _h = 0; _h < 2; ++_h) { vAc[_h][0] = PG8_TOKL(0, _h, 0); vAc[_h][1] = PG8_TOKL(0, _h, 1); }
            PG8_STAGE_B(PG8_SB(0, 0), cB); PG8_STAGE_B(PG8_SB(0, 1), cB + hstep); PG8_STAGE_G(PG8_SA(0, 0), 0, vAc, 0); PG8_STAGE_G(PG8_SA(0, 1), 0, vAc, 1);
        } else {
        PG8_STAGE_B(PG8_SB(0, 0), cB); PG8_STAGE_B(PG8_SB(0, 1), cB + hstep); PG8_STAGE_A(PG8_SA(0, 0), cA); PG8_STAGE_A(PG8_SA(0, 1), cA + hstep);
        }
        if (wr == 1) PG8_BAR;
        PG8_WAIT_V(2); PG8_BAR;
        if constexpr (GATHER) { PG8_STAGE_B(PG8_SB(1, 0), cB + kstep); PG8_STAGE_G(PG8_SA(1, 0), kstep, vAc, 0); PG8_STAGE_B(PG8_SB(1, 1), cB + hstep + kstep); }
        else {
        PG8_STAGE_B(PG8_SB(1, 0), cB + kstep); PG8_STAGE_A(PG8_SA(1, 0), cA + kstep); PG8_STAGE_B(PG8_SB(1, 1), cB + hstep + kstep);
        }
        PG8_WAIT_V(6); PG8_BAR;
    } else {
        PG8_STAGE_B(PG8_SB(0, 0), cB); PG8_STAGE_A(PG8_SA(0, 0), cA); PG8_STAGE_B(PG8_SB(0, 1), cB + hstep); PG8_STAGE_A(PG8_SA(0, 1), cA + hstep);
        if (wr == 1) PG8_BAR;
        PG8_WAIT_V(4); PG8_BAR;
        PG8_STAGE_B(PG8_SB(1, 0), cB + kstep); PG8_STAGE_A(PG8_SA(1, 0), cA + kstep); PG8_STAGE_B(PG8_SB(1, 1), cB + hstep + kstep);
        PG8_WAIT_V(6); PG8_BAR;
    }
    for (;;) {
        const bool has_next = S.next(ui + 1, nxt);
        const char* nA = has_next ? (const char*)g.A + (size_t)nxt.pm * tstep : cA; const char* nB = has_next ? (const char*)g.Bt + (size_t)nxt.pn * tstep : cB;
#pragma clang loop unroll(disable)
        for (int t = 0; t < nt; t += 2) {
            const bool last = (t == nt - 2);
            const char* a1 = cA + (size_t)(t + 1) * kstep;
            const char* a2 = last ? nA : cA + (size_t)(t + 2) * kstep; const char* b2 = last ? nB : cB + (size_t)(t + 2) * kstep;
            const char* a3 = a2 + kstep; const char* b3 = b2 + kstep;
            if (last && has_next) S.a_ready(nxt);
            const size_t kb2 = last ? (size_t)0 : (size_t)(t + 2) * kstep;
            if constexpr (SP2) {
            PG8_LDB(B0, 0, 0); PG8_LDB(B1, 0, 1); PG8_SCHED; PG8_LDA(At, 0, 0); if constexpr (GATHER) PG8_STAGE_G(PG8_SA(1, 1), (size_t)(t + 1) * kstep, vAc, 1); else PG8_STAGE_A(PG8_SA(1, 1), a1 + hstep);
            PG8_WAIT_V(8); PG8_WAIT_L(0); PG8_BAR; PG8_MMA(0, 0, At, B0); PG8_MMA(0, 1, At, B1); PG8_BAR; PG8_SCHED;
            if (!cur.hm) PG8_LDA(At, 0, 1); PG8_STAGE_B(PG8_SB(0, 0), b2); PG8_STAGE_B(PG8_SB(0, 1), b2 + hstep); if constexpr (GATHER) PG8_STAGE_G2(PG8_SA(0, 0), kb2, 0); else PG8_STAGE_A(PG8_SA(0, 0), a2);
            PG8_WAIT_V(8); PG8_WAIT_L(0); PG8_BAR; if (!cur.hm) { PG8_MMA(1, 0, At, B0); PG8_MMA(1, 1, At, B1); } PG8_BAR; PG8_SCHED;
            PG8_LDB(B0, 1, 0); PG8_LDB(B1, 1, 1); PG8_SCHED; PG8_LDA(At, 1, 0); if constexpr (GATHER) PG8_STAGE_G2(PG8_SA(0, 1), kb2, 1); else PG8_STAGE_A(PG8_SA(0, 1), a2 + hstep);
            PG8_WAIT_V(8); PG8_WAIT_L(0); PG8_BAR; PG8_MMA(0, 0, At, B0); PG8_MMA(0, 1, At, B1); PG8_BAR; PG8_SCHED;
            if (!cur.hm) PG8_LDA(At, 1, 1); PG8_STAGE_B(PG8_SB(1, 0), b3); PG8_STAGE_B(PG8_SB(1, 1), b3 + hstep); if constexpr (GATHER) PG8_STAGE_G2(PG8_SA(1, 0), kb2 + kstep, 0); else PG8_STAGE_A(PG8_SA(1, 0), a3);
            PG8_WAIT_V(8); PG8_WAIT_L(0); PG8_BAR; if (!cur.hm) { PG8_MMA(1, 0, At, B0); PG8_MMA(1, 1, At, B1); } PG8_BAR; PG8_SCHED;
            } else {
            PG8_LDB(B0, 0, 0); PG8_SCHED; PG8_LDA(At, 0, 0); PG8_STAGE_A(PG8_SA(1, 1), a1 + hstep);
            PG8_WAIT_L(8); PG8_BAR; PG8_WAIT_L(0); PG8_MMA(0, 0, At, B0); PG8_BAR; PG8_SCHED;
            PG8_LDB(B1, 0, 1); PG8_STAGE_B(PG8_SB(0, 0), b2);
            PG8_BAR; PG8_WAIT_L(0); PG8_MMA(0, 1, At, B1); PG8_BAR;
            PG8_LDA(At, 0, 1); PG8_STAGE_A(PG8_SA(0, 0), a2);
            PG8_BAR; PG8_WAIT_L(0); PG8_MMA(1, 0, At, B0); PG8_BAR; PG8_SCHED;
            PG8_STAGE_B(PG8_SB(0, 1), b2 + hstep);
            PG8_WAIT_V(6); PG8_BAR; PG8_MMA(1, 1, At, B1); PG8_BAR;
            PG8_LDB(B0, 1, 0); PG8_SCHED; PG8_LDA(At, 1, 0); PG8_STAGE_A(PG8_SA(0, 1), a2 + hstep);
            PG8_WAIT_L(8); PG8_BAR; PG8_WAIT_L(0); PG8_MMA(0, 0, At, B0); PG8_BAR; PG8_SCHED;
            PG8_LDB(B1, 1, 1); PG8_STAGE_B(PG8_SB(1, 0), b3);
            PG8_BAR; PG8_WAIT_L(0); PG8_MMA(0, 1, At, B1); PG8_BAR;
            PG8_LDA(At, 1, 1); PG8_STAGE_A(PG8_SA(1, 0), a3);
            PG8_BAR; PG8_WAIT_L(0); PG8_MMA(1, 0, At, B0); PG8_BAR; PG8_SCHED;
            PG8_STAGE_B(PG8_SB(1, 1), b3 + hstep);
            PG8_WAIT_V(6); PG8_BAR; PG8_MMA(1, 1, At, B1); PG8_BAR;
            }
        }
        if constexpr (ALIGN_EPI) { if (wr == 0) PG8_BAR; }
        if constexpr (!Epi::AFTER_DRAIN) { E(acc, cur, wr, wc, fr, fq); S.done(cur); }
        PP(ui);
        if (!has_next) break;
#pragma unroll
        for (int a = 0; a < 2; ++a)
#pragma unroll
            for (int b = 0; b < 2; ++b)
#pragma unroll
                for (int m = 0; m < 4; ++m)
#pragma unroll
                    for (int n = 0; n < 2; ++n) acc[a][b][m][n] = (f32x4){0.f, 0.f, 0.f, 0.f};
        cur = nxt; cA = nA; cB = nB; ++ui;
        if constexpr (GATHER) {
#pragma unroll
            for (int _h = 0; _h < 2; ++_h) { vAc[_h][0] = PG8_TOKL(ui, _h, 0); vAc[_h][1] = PG8_TOKL(ui, _h, 1); } }
        if constexpr (ALIGN_EPI) { if (wr == 1) PG8_BAR; }
    }
    PG8_WAIT_V(0);
    if constexpr (!ALIGN_EPI) { if (wr == 0) PG8_BAR; }
    PG8_BAR;
    if constexpr (Epi::AFTER_DRAIN) { E.fused(acc, cur, wr, wc, fr, fq, lds, wid, lane); S.done(cur); }
#undef PG8_SA
#undef PG8_SB
#undef PG8_STAGE_X
#undef PG8_STAGE_A
#undef PG8_STAGE_B
#undef PG8_STAGE_G
#undef PG8_STAGE_G2
#undef PG8_TOKL
#undef PG8_LDA
#undef PG8_LDB
#undef PG8_MMA
#undef PG8_WAIT_V
#undef PG8_WAIT_L
#undef PG8_BAR
#undef PG8_SCHED
}
}

#define GAS __attribute__((address_space(1)))
#define LAS __attribute__((address_space(3)))
typedef unsigned short bf16;
typedef unsigned v4u __attribute__((ext_vector_type(4)));
typedef unsigned v2u __attribute__((ext_vector_type(2)));
typedef float f32x4 __attribute__((ext_vector_type(4)));
typedef float f32x2 __attribute__((ext_vector_type(2)));
typedef short bf16x8 __attribute__((ext_vector_type(8)));
typedef GAS unsigned gu32;
#define RLX_AGENT __ATOMIC_RELAXED, __HIP_MEMORY_SCOPE_AGENT
#define LDS_WAIT() asm volatile("s_waitcnt lgkmcnt(0)" ::: "memory")
#define VM_WAIT() asm volatile("s_waitcnt vmcnt(0)" ::: "memory")
__device__ __forceinline__ unsigned f2bf(float f) { unsigned u = __builtin_bit_cast(unsigned, f); return (u + 0x7fffu + ((u >> 16) & 1u)) >> 16; }
__device__ __forceinline__ unsigned pk2(float lo, float hi) { return pg8::cvt_pk_bf16(lo, hi); }
__device__ __forceinline__ float bflo(unsigned w) { return __builtin_bit_cast(float, w << 16); }
__device__ __forceinline__ float bfhi(unsigned w) { return __builtin_bit_cast(float, w & 0xffff0000u); }
__device__ __forceinline__ float wave_sum(float v) {
#pragma unroll
    for (int o = 1; o < 64; o <<= 1) v += __shfl_xor(v, o);
    return v;
}

#define XB_TMO      128
#define XB_XCNT(j)  (256  + 64 * (j))
#define XB_XSUB(j)  (1280 + 64 * (j))
#define XB_XGEN(j)  (2304 + 64 * (j))
#define XB_TOP      3328
#define XB_TOPGEN   3392
#define XCD_BAR_WORDS 3456
#define XB_SPIN_CAP (1u << 18)

__device__ __forceinline__ unsigned xb_ld(unsigned* p)              { return __hip_atomic_load(p, __ATOMIC_RELAXED, __HIP_MEMORY_SCOPE_AGENT); }
__device__ __forceinline__ unsigned xb_add(unsigned* p, unsigned v) { return __hip_atomic_fetch_add(p, v, __ATOMIC_RELAXED, __HIP_MEMORY_SCOPE_AGENT); }
__device__ __forceinline__ unsigned xb_xcc_id() { return (unsigned)__builtin_amdgcn_s_getreg((3 << 11) | 20) & 0xFu; }
#define XB_SPIN(cond, bar) do { unsigned _sp = 0; while (cond) { __builtin_amdgcn_s_sleep(1); \
    if ((++_sp & 255u) == 0u) { if (xb_ld(&(bar)[XB_TMO])) break; if (_sp > XB_SPIN_CAP) { atomicAdd(&(bar)[XB_TMO], 1u); break; } } } } while (0)

struct XcdBarrier {
    unsigned* bar; unsigned x;
    volatile LAS unsigned* st;
};

__device__ __forceinline__ XcdBarrier xcd_barrier_post(unsigned* bar, volatile LAS unsigned* st) {
    XcdBarrier b; b.bar = bar; b.x = xb_xcc_id(); b.st = st;
    if (threadIdx.x == 0) (void)xb_add(&bar[XB_XCNT(b.x)], 1u);
    return b;
}
__device__ __forceinline__ void xcd_barrier_complete(unsigned* bar, unsigned x, unsigned& nloc, unsigned& nx) {
    const unsigned G = gridDim.x * gridDim.y * gridDim.z;
    unsigned sum, cnt, mine, sp = 0u;
    for (;;) {
        sum = 0u; cnt = 0u; mine = 0u;
#pragma unroll
        for (unsigned j = 0; j < 16; ++j) { const unsigned c = xb_ld(&bar[XB_XCNT(j)]); sum += c; cnt += (c > 0u) ? 1u : 0u; mine = (j == x) ? c : mine; }
        if (sum == G) break;
        __builtin_amdgcn_s_sleep(1);
        if ((++sp & 255u) == 0u) { if (xb_ld(&bar[XB_TMO])) break; if (sp > XB_SPIN_CAP) { atomicAdd(&bar[XB_TMO], 1u); break; } }
    }
    nloc = mine > 0u ? mine : 1u; nx = cnt > 0u ? cnt : 1u;
}

__device__ __forceinline__ void xcd_barrier(const XcdBarrier& b) {
    asm volatile("s_waitcnt vmcnt(0)" ::: "memory");
    __syncthreads();
    if (threadIdx.x == 0) {
        unsigned* bar = b.bar;
        __builtin_amdgcn_s_waitcnt(0);
        unsigned nloc = b.st[0], nx = b.st[1];
        if (nloc == 0u) { xcd_barrier_complete(bar, b.x, nloc, nx); b.st[0] = nloc; b.st[1] = nx; }
        const unsigned old = xb_add(&bar[XB_XSUB(b.x)], 1u);
        const unsigned gen = old / nloc;
        if (old + 1u == (gen + 1u) * nloc) {
            __builtin_amdgcn_fence(__ATOMIC_RELEASE, "agent");
            asm volatile("s_waitcnt vmcnt(0)" ::: "memory");
            const unsigned og = xb_add(&bar[XB_TOP], 1u);
            const unsigned tg = og / nx;
            if (og + 1u == (tg + 1u) * nx) xb_add(&bar[XB_TOPGEN], 1u);
            else XB_SPIN(xb_ld(&bar[XB_TOPGEN]) == tg, bar);
            __builtin_amdgcn_fence(__ATOMIC_ACQUIRE, "agent");
            xb_add(&bar[XB_XGEN(b.x)], 1u);
            asm volatile("s_waitcnt vmcnt(0)" ::: "memory");
        } else {
            XB_SPIN(xb_ld(&bar[XB_XGEN(b.x)]) == gen, bar);
            __builtin_amdgcn_fence(__ATOMIC_ACQUIRE, "agent");
            asm volatile("s_waitcnt vmcnt(0)" ::: "memory");
        }
    }
    __syncthreads();
}

constexpr int NWAVES = 8;
constexpr int D = 1024, NBATCH = 4, T = 8192, M = NBATCH * T;
constexpr int NPROJ = 6144, NE = 64, DE = 512;
constexpr int CAP = 2 * M + NE * 256;
constexpr int NBLK = M / 128;
constexpr float LN_EPS = 1e-5f;
constexpr float ALPHA = 1.18920711500272f;
constexpr size_t MiB = 1u << 20;
constexpr size_t WS_CTL = 0, CTL_ZERO_BYTES = 65536;
constexpr int CW_GCNT = 8192;
constexpr int CAPE = M;
constexpr size_t WS_TAB = 100 * MiB;
constexpr int NKC = 8;
constexpr size_t WS_MODP = 96 * MiB;
constexpr size_t WS_MOD = 1 * MiB + 512 * 1024;
constexpr size_t WS_GCBC = 1 * MiB + 768 * 1024;
constexpr size_t WS_RW = 2 * MiB;
constexpr size_t WS_STATP = 5 * MiB;
constexpr size_t WS_RAW = 26 * MiB;
constexpr size_t WS_WIN = 10 * MiB, WS_WOC = 22 * MiB, WS_WO = 24 * MiB, WS_WGU = 32 * MiB, WS_WD = 160 * MiB;
constexpr size_t WS_U = 224 * MiB, WS_A2 = WS_U, WS_H = WS_U;
constexpr size_t WS_Q = 288 * MiB, WS_MG = 480 * MiB;
constexpr size_t WS_GA = 352 * MiB, WS_GB = 416 * MiB, WS_PQG = 480 * MiB;
constexpr size_t WS_ACT = 480 * MiB, WS_O = 352 * MiB;
constexpr size_t WS_END = 560 * MiB;
static_assert(WS_ACT + (size_t)CAP * DE * 2 <= 560 * MiB && WS_O + (size_t)2 * M * D * 2 <= WS_ACT, "d_ws map");
constexpr int CW_TMO = 0, CW_BAR = 1024;
constexpr int RING_OFF = 0, RING_BYTES = 131072;
constexpr int MISC_OFF = 135168;
constexpr int LT_PADSTART = MISC_OFF + 128;
constexpr int LT_TILEE = MISC_OFF + 512;
constexpr int LT_HIST = MISC_OFF + 2048;
constexpr int LT_TOT = MISC_OFF + 2304, LT_BASE = MISC_OFF + 2560;
constexpr int LT_AE = MISC_OFF + 3072, LT_APOS = MISC_OFF + 4096;
constexpr int LT_PSUM = MISC_OFF + 5120;
constexpr int LT_CONVW = 147456;
constexpr int LDS_BYTES = 159744;
static_assert(LT_PSUM + 4096 <= LDS_BYTES && LT_HIST + 5 * 256 * 8 <= LDS_BYTES, "LDS map");

struct Frame {
    LAS unsigned char* lds; unsigned char* ldsg;
    gu32* ctl;
    int tid, lane, wave, G;
    const float *x, *c, *w_ada, *b_ada, *w_in, *conv_w, *w_out_conv, *w_pool, *pool_scale, *w_o, *ln1_g, *ln1_b, *w_group, *b_group, *w_router, *b_router, *w_gate, *w_up, *w_down, *ln2_g, *ln2_b;
    float* out; unsigned char* ws;
};

__device__ __forceinline__ void p0a_mod(Frame& F) {
    LAS float* sc = (LAS float*)(F.lds);
    LAS float* red = (LAS float*)(F.lds + 16384);
    float* modp = (float*)(F.ws + WS_MODP);
    float w[3][16];
#pragma unroll
    for (int r = 0; r < 3; ++r) { const int u = blockIdx.x + r * F.G; if (u < NKC * 96) { const int cg = u >> 3, kc = u & 7;
        const float* wp = F.w_ada + (size_t)(kc * 128 + F.wave * 16) * NPROJ + cg * 64 + F.lane;
#pragma unroll
        for (int i = 0; i < 16; ++i) w[r][i] = __builtin_nontemporal_load(wp + (size_t)i * NPROJ); } }
    { float cv[8];
#pragma unroll
      for (int i = 0; i < 8; ++i) cv[i] = F.c[F.tid + 512 * i];
#pragma unroll
      for (int i = 0; i < 8; ++i) sc[F.tid + 512 * i] = cv[i] / (1.0f + __expf(-cv[i])); }
    __syncthreads();
#pragma unroll
    for (int r = 0; r < 3; ++r) { const int u = blockIdx.x + r * F.G; if (u >= NKC * 96) break;
        const int cg = u >> 3, kc = u & 7, k0 = kc * 128 + F.wave * 16;
        float a0 = 0.f, a1 = 0.f, a2 = 0.f, a3 = 0.f;
#pragma unroll
        for (int i = 0; i < 16; ++i) { const int k = k0 + i; a0 += sc[k] * w[r][i]; a1 += sc[1024 + k] * w[r][i]; a2 += sc[2048 + k] * w[r][i]; a3 += sc[3072 + k] * w[r][i]; }
        red[(F.wave * 4 + 0) * 64 + F.lane] = a0; red[(F.wave * 4 + 1) * 64 + F.lane] = a1; red[(F.wave * 4 + 2) * 64 + F.lane] = a2; red[(F.wave * 4 + 3) * 64 + F.lane] = a3;
        __syncthreads();
        if (F.wave < 4) { float s = 0.f;
#pragma unroll
            for (int w8 = 0; w8 < 8; ++w8) s += red[(w8 * 4 + F.wave) * 64 + F.lane];
            modp[((size_t)kc * 4 + F.wave) * NPROJ + cg * 64 + F.lane] = s; }
        __syncthreads();
    }
}

__device__ __forceinline__ int conv_row(int tau, int c) { return 128 * (tau >> 1) + 32 * (c >> 4) + 8 * ((c >> 2) & 3) + 4 * (tau & 1) + (c & 3); }
__device__ __forceinline__ void transpose_item(const float* W, int ld, int src_col0, bf16* dst, int K, int dst_row0, int k0, LAS float* scr, int lane, int tau = -1) {
    float tv[64]; const float* wsrc = W + (size_t)k0 * ld + src_col0 + lane;
#pragma unroll
    for (int i = 0; i < 64; ++i) tv[i] = wsrc[(size_t)i * ld];
#pragma unroll
    for (int i = 0; i < 64; ++i) scr[i * 65 + lane] = tv[i];
    LDS_WAIT(); asm volatile("" ::: "memory");
    const int c = lane & 7, nn = lane >> 3;
#pragma unroll
    for (int j = 0; j < 8; ++j) { const int n = nn + 8 * j; const LAS float* s = scr + (8 * c) * 65 + n;
        v4u o; o.x = pk2(s[0 * 65], s[1 * 65]); o.y = pk2(s[2 * 65], s[3 * 65]); o.z = pk2(s[4 * 65], s[5 * 65]); o.w = pk2(s[6 * 65], s[7 * 65]);
        const int drow = dst_row0 + (tau < 0 ? n : conv_row(tau, n));
        *(GAS v4u*)(dst + (size_t)drow * K + k0 + 8 * c) = o; }
    LDS_WAIT(); asm volatile("" ::: "memory");
}
constexpr int NT_ITEMS = 1280 + 256 + 256;
__device__ __forceinline__ void p0b_transpose(Frame& F, int it, LAS float* scr) {
    bf16* WinT = (bf16*)(F.ws + WS_WIN);
    if (it < 1280) { const int seg = it >> 8, r = it & 255, kb = r >> 4, nb = r & 15;
        if (seg < 4) transpose_item(F.w_in, NPROJ, (seg == 0 ? 0 : seg == 1 ? 2048 : seg == 2 ? 1024 : 4096) + 64 * nb, WinT, D, 256 * nb, 64 * kb, scr, F.lane, seg);
        else transpose_item(F.w_in, NPROJ, 5120 + 64 * nb, WinT, D, 5120 + 64 * nb, 64 * kb, scr, F.lane);
        return; }
    it -= 1280;
    if (it < 256) { const int kb = it >> 4, nb = it & 15; transpose_item(F.w_out_conv, D, 64 * nb, (bf16*)(F.ws + WS_WOC), D, 64 * nb, 64 * kb, scr, F.lane); return; }
    it -= 256;
    if (it < 256) { const int kb = it >> 4, nb = it & 15; transpose_item(F.w_o, D, 64 * nb, (bf16*)(F.ws + WS_WO), D, 64 * nb, 64 * kb, scr, F.lane); return; }
}
constexpr int NCONV = 32;
struct XItem { const float* src; unsigned char* dst; int ld, K, r1; };
__device__ __forceinline__ XItem expert_item(Frame& F, int j) {
    XItem x; const int half = (j >> 11) & 1; int p = ((j >> 12) << 11) | (j & 2047);
    if (p < 8192) { const int up = p >= 4096 ? 1 : 0; p &= 4095; const int e = p >> 6, r = p & 63, kb = 2 * (r >> 3) + half, nb = r & 7;
        x.ld = DE; x.K = D; x.src = (up ? F.w_up : F.w_gate) + (size_t)e * D * DE + (size_t)(64 * kb) * DE + 64 * nb;
        x.r1 = 32; x.dst = (F.ws + WS_WGU) + (size_t)e * D * D + (size_t)(256 * (nb >> 1) + 128 * up + 64 * (nb & 1)) * D + 128 * (r >> 3); return x; }
    p -= 8192;
    { const int e = p >> 6, r = p & 63, kb = 2 * (r >> 4) + half, nb = r & 15;
        x.ld = D; x.K = DE; x.src = F.w_down + (size_t)e * DE * D + (size_t)(64 * kb) * D + 64 * nb;
        x.r1 = 128; x.dst = (F.ws + WS_WD) + (size_t)e * D * DE + (size_t)(256 * (nb >> 2) + 32 * (nb & 3)) * DE + 128 * (r >> 4); return x; }
}
__device__ __forceinline__ void xitem_load(const XItem& x, float (&tv)[64], int lane) {
    const float* wsrc = x.src + lane;
#pragma unroll
    for (int i = 0; i < 64; ++i) tv[i] = __builtin_nontemporal_load(wsrc + (size_t)i * x.ld);
}
__device__ __forceinline__ void xitem_pack(const float (&tv)[64], LAS float* scr, int lane, v2u (&o)[8]) {
#pragma unroll
    for (int i = 0; i < 64; ++i) scr[i * 65 + lane] = tv[i];
    LDS_WAIT(); asm volatile("" ::: "memory");
    const int c = lane & 7, nn = lane >> 3;
#pragma unroll
    for (int j = 0; j < 8; ++j) { const int n = nn + 8 * j; const LAS float* sp = scr + (8 * c) * 65 + n;
        const float ws_ = pg8::W8_SCALE;
        o[j] = (v2u){pg8::pk4_fp8(sp[0 * 65] * ws_, sp[1 * 65] * ws_, sp[2 * 65] * ws_, sp[3 * 65] * ws_), pg8::pk4_fp8(sp[4 * 65] * ws_, sp[5 * 65] * ws_, sp[6 * 65] * ws_, sp[7 * 65] * ws_)}; }
    LDS_WAIT(); asm volatile("" ::: "memory");
}
__device__ __forceinline__ void xpair_store(const XItem& x, const v2u (&oa)[8], const v2u (&ob)[8], int lane) {
    const int c = lane & 7, nn = lane >> 3; const bool odd = (c & 1) != 0;
#pragma unroll
    for (int j = 0; j < 8; ++j) { const int n = nn + 8 * j; const v2u snd = odd ? oa[j] : ob[j]; v2u rcv; rcv.x = __shfl_xor(snd.x, 1); rcv.y = __shfl_xor(snd.y, 1);
        const v4u w = odd ? (v4u){rcv.x, rcv.y, ob[j].x, ob[j].y} : (v4u){oa[j].x, oa[j].y, rcv.x, rcv.y};
        __builtin_nontemporal_store(w, (GAS v4u*)(x.dst + (size_t)((n & 31) + (n >> 5) * x.r1) * x.K + (odd ? 64 + 8 * (c - 1) : 8 * c))); }
}
__device__ __forceinline__ void convert_experts(Frame& F, int rank, int nranks) {
    LAS float* scr = (LAS float*)(F.lds + F.wave * 16640);
    const int st = nranks * NWAVES; int it = rank * NWAVES + F.wave;
    if (it >= 3 * 8192) return;
    float ta[64], tb[64]; v2u oa[8], ob[8]; XItem xa = expert_item(F, it), xb = xa;
    xitem_load(xa, ta, F.lane);
    for (;;) {
        xb = expert_item(F, it + st); xitem_load(xb, tb, F.lane);
        xitem_pack(ta, scr, F.lane, oa);
        const XItem xs = xa;
        it += 2 * st; const bool ha = it < 3 * 8192;
        if (ha) { xa = expert_item(F, it); xitem_load(xa, ta, F.lane); }
        xitem_pack(tb, scr, F.lane, ob);
        xpair_store(xs, oa, ob, F.lane);
        if (!ha) break;
    }
}
__device__ __forceinline__ void p0b_fold(Frame& F, int it, LAS float* scr) {
    const int g = it >> 9, r = it & 511, k0 = (r >> 2) * 8, e = (r & 3) * 64 + F.lane;
    float acc[8];
#pragma unroll
    for (int kk = 0; kk < 8; ++kk) acc[kk] = 0.f;
    const float* wp = F.w_pool + (size_t)g * 65536 + e;
    const float* wi = F.w_in + (size_t)k0 * NPROJ + 3072 + g * 256;
#pragma unroll
    for (int kk = 0; kk < 8; ++kk) ((LAS f32x4*)scr)[kk * 64 + F.lane] = *(const f32x4*)(wi + (size_t)kk * NPROJ + 4 * F.lane);
    float p0[16], p1[16];
#pragma unroll
    for (int j = 0; j < 16; ++j) p0[j] = wp[j * 256];
    LDS_WAIT(); asm volatile("" ::: "memory");
#define FOLD_STEP(PC, PN, S, MORE) { if (MORE) { _Pragma("unroll") for (int j = 0; j < 16; ++j) PN[j] = wp[(((S) + 1) * 16 + j) * 256]; } \
        _Pragma("unroll") for (int j = 0; j < 16; j += 4) { asm volatile("" ::: "memory"); \
            _Pragma("unroll") for (int kk = 0; kk < 8; ++kk) { const f32x4 w = *(const LAS f32x4*)(scr + kk * 256 + (S) * 16 + j); \
                acc[kk] += (w[0] * PC[j] + w[1] * PC[j + 1]) + (w[2] * PC[j + 2] + w[3] * PC[j + 3]); } } }
#pragma clang loop unroll(disable)
    for (int s8 = 0; s8 < 16; s8 += 2) {
        FOLD_STEP(p0, p1, s8, true)
        FOLD_STEP(p1, p0, s8 + 1, s8 + 2 < 16)
    }
#undef FOLD_STEP
    LDS_WAIT(); asm volatile("" ::: "memory");
    const float ps = F.pool_scale[g * 256 + e];
    v4u o0;
    o0.x = pk2(acc[0] * ps, acc[1] * ps); o0.y = pk2(acc[2] * ps, acc[3] * ps); o0.z = pk2(acc[4] * ps, acc[5] * ps); o0.w = pk2(acc[6] * ps, acc[7] * ps);
    bf16* dst = (bf16*)(F.ws + WS_WIN) + (size_t)(4096 + g * 256 + e) * D + k0;
    *(GAS v4u*)dst = o0;
}
__device__ __forceinline__ void p0b_rw(Frame& F, int it) {
    const int ks = it / 5, j = it - ks * 5, col = 16 * j + (F.lane & 15), kb = 32 * ks + 8 * (F.lane >> 4);
    float v[8];
#pragma unroll
    for (int e = 0; e < 8; ++e) { const int k = kb + e; const float* src = col < 8 ? F.w_group + k * 8 + col : F.w_router + k * 64 + (col < 72 ? col - 8 : 0); const float t = *src; v[e] = col < 72 ? t : 0.f; }
    unsigned hi[4], lo[4];
#pragma unroll
    for (int i = 0; i < 4; ++i) { const unsigned h0 = f2bf(v[2 * i]), h1 = f2bf(v[2 * i + 1]); hi[i] = h0 | (h1 << 16);
        lo[i] = pk2(v[2 * i] - __builtin_bit_cast(float, h0 << 16), v[2 * i + 1] - __builtin_bit_cast(float, h1 << 16)); }
    v4u* rw = (v4u*)(F.ws + WS_RW);
    rw[(size_t)(it * 2 + 0) * 64 + F.lane] = (v4u){hi[0], hi[1], hi[2], hi[3]};
    rw[(size_t)(it * 2 + 1) * 64 + F.lane] = (v4u){lo[0], lo[1], lo[2], lo[3]};
}
__device__ __forceinline__ void p0b_prologue(Frame& F) {
    const float* modp = (const float*)(F.ws + WS_MODP);
    const int blk = blockIdx.x, b = blk >> 6;
    LAS f32x4* ml = (LAS f32x4*)(F.lds + 4 * 16640);
    { const int c4 = 4 * F.tid; f32x4 pv[NKC], acc = *(const f32x4*)(F.b_ada + c4);
#pragma unroll
      for (int kc = 0; kc < NKC; ++kc) pv[kc] = *(const f32x4*)(modp + ((size_t)kc * 4 + b) * NPROJ + c4);
#pragma unroll
      for (int kc = 0; kc < NKC; ++kc) acc += pv[kc];
      ml[F.tid] = F.tid >= 256 ? acc + 1.0f : acc; }
    __syncthreads();
    if (F.wave >= 4) {
        bf16* U = (bf16*)(F.ws + WS_U);
        f32x4 s1[4], sh1[4];
#pragma unroll
        for (int j = 0; j < 4; ++j) { sh1[j] = ml[F.lane + 64 * j]; s1[j] = ml[256 + F.lane + 64 * j]; }
        for (int rr = 0; rr < 32; rr += 8) { const size_t row = (size_t)blk * 128 + (F.wave - 4) * 32 + rr;
            const GAS f32x4* xr = (const GAS f32x4*)(F.x + row * D) + F.lane; GAS v2u* ur = (GAS v2u*)(U + row * D) + F.lane;
            f32x4 xv[8][4];
#pragma unroll
            for (int q = 0; q < 8; ++q)
#pragma unroll
                for (int j = 0; j < 4; ++j) xv[q][j] = __builtin_nontemporal_load(xr + q * 256 + 64 * j);
#pragma unroll
            for (int q = 0; q < 8; ++q)
#pragma unroll
                for (int j = 0; j < 4; ++j) { const f32x4 v = xv[q][j] * s1[j] + sh1[j]; ur[q * 256 + 64 * j] = (v2u){pk2(v[0], v[1]), pk2(v[2], v[3])}; } }
        return;
    }
    const int gw = blockIdx.x * 4 + F.wave, NGW = F.G * 4;
    LAS float* scr = (LAS float*)(F.lds + F.wave * 16640);
    for (int it = gw; it < 2048; it += NGW) p0b_fold(F, it, scr);
    for (int it = NGW - 1 - gw; it < 160; it += NGW) p0b_rw(F, it);
    for (int gid = gw * 64 + F.lane; gid < NBATCH * NPROJ; gid += NGW * 64) { const int bq = gid / NPROJ, j = gid - bq * NPROJ;
        float s = F.b_ada[j];
#pragma unroll
        for (int kc = 0; kc < NKC; ++kc) s += modp[((size_t)kc * 4 + bq) * NPROJ + j];
        ((float*)(F.ws + WS_MOD))[gid] = s;
        if (gid < NBATCH * D) { const int bb = gid >> 10, cc = gid & 1023; float s2 = F.b_ada[4096 + cc], sh2 = F.b_ada[3072 + cc];
#pragma unroll
            for (int kc = 0; kc < NKC; ++kc) { s2 += modp[((size_t)kc * 4 + bb) * NPROJ + 4096 + cc]; sh2 += modp[((size_t)kc * 4 + bb) * NPROJ + 3072 + cc]; }
            float* gcbc = (float*)(F.ws + WS_GCBC); gcbc[gid] = F.ln1_g[cc] * (1.0f + s2); gcbc[NBATCH * D + gid] = F.ln1_b[cc] * (1.0f + s2) + sh2; } }
    for (int it = gw; it < NT_ITEMS; it += NGW) p0b_transpose(F, it, scr);
}

__device__ __forceinline__ void unpack8(const v4u w, float (&f)[8]) { f[0] = bflo(w.x); f[1] = bfhi(w.x); f[2] = bflo(w.y); f[3] = bfhi(w.y); f[4] = bflo(w.z); f[5] = bfhi(w.z); f[6] = bflo(w.w); f[7] = bfhi(w.w); }
__device__ __forceinline__ v4u pack8f(const float (&f)[8]) { return (v4u){pk2(f[0], f[1]), pk2(f[2], f[3]), pk2(f[4], f[5]), pk2(f[6], f[7])}; }
__device__ __forceinline__ void conv_fixup2(Frame& F, int pm0, int pm1, int n) {
    bf16* A2 = (bf16*)F.out;
    const bf16* VH = (const bf16*)(F.ws + WS_RAW); const bf16* ABH = VH + 128 * 2 * 1024; const bf16* VT = VH + 2 * 128 * 2 * 1024;
    const int r = F.tid >> 8, ch0 = (F.tid & 255) * 4;
    const f32x4 w0 = *(const f32x4*)(F.conv_w + ch0), w1 = *(const f32x4*)(F.conv_w + 1024 + ch0), w2 = *(const f32x4*)(F.conv_w + 2048 + ch0);
    v2u vh0[2], vh1[2], ab[2], t0[2], t1[2];
#pragma unroll
    for (int i = 0; i < 2; ++i) { const int pm = i == 0 ? pm0 : pm1;
        vh0[i] = *(const GAS v2u*)(VH + (size_t)(pm * 2 + 0) * 1024 + ch0); vh1[i] = *(const GAS v2u*)(VH + (size_t)(pm * 2 + 1) * 1024 + ch0); ab[i] = *(const GAS v2u*)(ABH + (size_t)(pm * 2 + r) * 1024 + ch0);
        t0[i] = (v2u){0u, 0u}; t1[i] = (v2u){0u, 0u};
        if (((pm * 256) & (T - 1)) > 0) { t0[i] = *(const GAS v2u*)(VT + (size_t)((pm - 1) * 2 + 0) * 1024 + ch0); t1[i] = *(const GAS v2u*)(VT + (size_t)((pm - 1) * 2 + 1) * 1024 + ch0); } }
#pragma unroll
    for (int i = 0; i < 2; ++i) { if (i >= n) break; const int pm = i == 0 ? pm0 : pm1;
        const f32x4 V0 = (f32x4){bflo(vh0[i].x), bfhi(vh0[i].x), bflo(vh0[i].y), bfhi(vh0[i].y)}, V1 = (f32x4){bflo(vh1[i].x), bfhi(vh1[i].x), bflo(vh1[i].y), bfhi(vh1[i].y)};
        const f32x4 T0 = (f32x4){bflo(t0[i].x), bfhi(t0[i].x), bflo(t0[i].y), bfhi(t0[i].y)}, T1 = (f32x4){bflo(t1[i].x), bfhi(t1[i].x), bflo(t1[i].y), bfhi(t1[i].y)}, AB = (f32x4){bflo(ab[i].x), bfhi(ab[i].x), bflo(ab[i].y), bfhi(ab[i].y)};
        const f32x4 o = (r == 0 ? (w0 * T0 + w1 * T1 + w2 * V0) : (w0 * T1 + w1 * V0 + w2 * V1)) * AB;
        *(GAS v2u*)(A2 + (size_t)(pm * 256 + r) * D + ch0) = (v2u){pk2(o[0], o[1]), pk2(o[2], o[3])}; }
}

__device__ __forceinline__ void p4_route(Frame& F) {
    const float* z = F.out; const f32x2* statp = (const f32x2*)(F.ws + WS_STATP);
    const float* gcbc = (const float*)(F.ws + WS_GCBC); const v4u* rw = (const v4u*)(F.ws + WS_RW);
    unsigned char* H = F.ws + WS_H;
    LAS int* hist = (LAS int*)(F.lds + LT_HIST);
    LAS float* lg = (LAS float*)(F.lds + F.wave * 5120);
    const int r = F.lane & 15, q = F.lane >> 4;
    for (int blk = blockIdx.x; blk < NBLK; blk += F.G) {
        if (F.tid < 64) hist[F.tid] = 0;
        __syncthreads();
        const int row = blk * 128 + F.wave * 16 + r, b = blk >> 6;
        float s = 0.f, qq = 0.f;
#pragma unroll
        for (int i = 0; i < 4; ++i) { const f32x2 p = statp[(size_t)row * 16 + q * 4 + i]; s += p.x; qq += p.y; }
        s += __shfl_xor(s, 16); s += __shfl_xor(s, 32); qq += __shfl_xor(qq, 16); qq += __shfl_xor(qq, 32);
        const float mean = s * (1.0f / D), rstd = 1.0f / sqrtf(qq * (1.0f / D) - mean * mean + LN_EPS);
        pg8::f32x4 acc[5];
#pragma unroll
        for (int j = 0; j < 5; ++j) acc[j] = (pg8::f32x4){0.f, 0.f, 0.f, 0.f};
        const float* zr = z + (size_t)(blk * 128 + F.wave * 16 + (r & 7)) * D + 8 * q + 4 * (r >> 3);
        LAS unsigned char* hst = F.lds + F.wave * 5120;
        LAS float* gcl = (LAS float*)(F.lds + 122880); LAS float* bcl = gcl + D;
        LAS unsigned char* bb = F.lds + 40960;
        for (int i = F.tid; i < D / 4; i += 512) { ((LAS f32x4*)gcl)[i] = ((const f32x4*)(gcbc + b * D))[i]; ((LAS f32x4*)bcl)[i] = ((const f32x4*)(gcbc + NBATCH * D + b * D))[i]; }
        LAS float* brl = (LAS float*)(F.lds + 131072);
        if (F.tid >= 256 && F.tid < 256 + 72) { const int t = F.tid - 256; brl[t] = t < 8 ? F.b_group[t] : F.b_router[t - 8]; }
        const v4u* rwl = rw + F.wave * 64 + F.lane;
        v4u br[4][2]; f32x4 zq[4][2];
#pragma unroll
        for (int k = 0; k < 4; ++k) { br[k][0] = rwl[(size_t)k * 640]; br[k][1] = F.wave < 2 ? rwl[(size_t)k * 640 + 512] : (v4u){0u, 0u, 0u, 0u}; }
#pragma unroll
        for (int k = 0; k < 4; ++k) { zq[k][0] = __builtin_nontemporal_load((const f32x4*)(zr + 32 * k)); zq[k][1] = __builtin_nontemporal_load((const f32x4*)(zr + 8 * D + 32 * k)); }
#pragma unroll
        for (int k = 0; k < 4; ++k) { LAS v4u* d0 = (LAS v4u*)(bb + k * 10240) + F.wave * 64 + F.lane; d0[0] = br[k][0]; if (F.wave < 2) d0[512] = br[k][1]; }
#pragma unroll
        for (int k = 0; k < 4; ++k) { br[k][0] = rwl[(size_t)(4 + k) * 640]; if (F.wave < 2) br[k][1] = rwl[(size_t)(4 + k) * 640 + 512]; }
        __syncthreads();
        for (int ks0 = 0; ks0 < 32; ks0 += 4) {
#pragma unroll
        for (int u = 0; u < 4; ++u) { const int ks = ks0 + u;
            f32x4 z0, z1;
#pragma unroll
            for (int e = 0; e < 4; ++e) { z0[e] = pg8::dpp_fill<0x118>(zq[u][0][e], zq[u][1][e]); z1[e] = pg8::dpp_fill<0x108>(zq[u][1][e], zq[u][0][e]); }
            if (ks + 4 < 32) { zq[u][0] = __builtin_nontemporal_load((const f32x4*)(zr + 32 * (ks + 4))); zq[u][1] = __builtin_nontemporal_load((const f32x4*)(zr + 8 * D + 32 * (ks + 4))); }
            const f32x4 g0 = *(const LAS f32x4*)(gcl + 32 * ks + 8 * q), g1 = *(const LAS f32x4*)(gcl + 32 * ks + 8 * q + 4), b0 = *(const LAS f32x4*)(bcl + 32 * ks + 8 * q), b1 = *(const LAS f32x4*)(bcl + 32 * ks + 8 * q + 4);
            const f32x4 h0 = (z0 - mean) * rstd * g0 + b0, h1 = (z1 - mean) * rstd * g1 + b1;
            const float hv[8] = {h0[0], h0[1], h0[2], h0[3], h1[0], h1[1], h1[2], h1[3]};
            unsigned hi[4], lo[4];
#pragma unroll
            for (int i = 0; i < 4; ++i) { hi[i] = pk2(hv[2 * i], hv[2 * i + 1]);
                lo[i] = pk2(hv[2 * i] - __builtin_bit_cast(float, hi[i] << 16), hv[2 * i + 1] - __builtin_bit_cast(float, hi[i] & 0xffff0000u)); }
            const v4u hiv = (v4u){hi[0], hi[1], hi[2], hi[3]}, lov = (v4u){lo[0], lo[1], lo[2], lo[3]};
            *(LAS v2u*)(hst + r * 144 + u * 32 + q * 8) = (v2u){pg8::pk4_fp8(hv[0], hv[1], hv[2], hv[3]), pg8::pk4_fp8(hv[4], hv[5], hv[6], hv[7])};
            if (u == 3) {
#pragma unroll
                for (int j = 0; j < 2; ++j) { const int rw_ = 8 * j + (F.lane >> 3), c16 = F.lane & 7;
                    const v4u t = *(const LAS v4u*)(hst + rw_ * 144 + c16 * 16);
                    *(GAS v4u*)(H + (size_t)(blk * 128 + F.wave * 16 + rw_) * D + 32 * (ks - 3) + c16 * 16) = t; } }
            const pg8::bf16x8 Ah = __builtin_bit_cast(pg8::bf16x8, hiv), Al = __builtin_bit_cast(pg8::bf16x8, lov);
            const LAS v4u* bl = (const LAS v4u*)(bb + ((ks0 >> 2) & 1) * 40960 + u * 10240) + F.lane;
#pragma unroll
            for (int j = 0; j < 5; ++j) { const pg8::bf16x8 Bh = __builtin_bit_cast(pg8::bf16x8, bl[(j * 2 + 0) * 64]), Bl = __builtin_bit_cast(pg8::bf16x8, bl[(j * 2 + 1) * 64]);
                acc[j] = __builtin_amdgcn_mfma_f32_16x16x32_bf16(Ah, Bh, acc[j], 0, 0, 0);
                acc[j] = __builtin_amdgcn_mfma_f32_16x16x32_bf16(Al, Bh, acc[j], 0, 0, 0);
                acc[j] = __builtin_amdgcn_mfma_f32_16x16x32_bf16(Ah, Bl, acc[j], 0, 0, 0); }
        }
            if (ks0 + 4 < 32) {
#pragma unroll
                for (int k = 0; k < 4; ++k) { LAS v4u* d1 = (LAS v4u*)(bb + (((ks0 >> 2) + 1) & 1) * 40960 + k * 10240) + F.wave * 64 + F.lane; d1[0] = br[k][0]; if (F.wave < 2) d1[512] = br[k][1]; } }
            if (ks0 + 8 < 32) {
#pragma unroll
                for (int k = 0; k < 4; ++k) { br[k][0] = rwl[(size_t)(ks0 + 8 + k) * 640]; if (F.wave < 2) br[k][1] = rwl[(size_t)(ks0 + 8 + k) * 640 + 512]; } }
            __syncthreads();
        }
#pragma unroll
        for (int j = 0; j < 5; ++j)
#pragma unroll
            for (int g = 0; g < 4; ++g) lg[(4 * q + g) * 80 + 16 * j + r] = acc[j][g];
        __syncthreads();
        int E1 = 0, E2 = 0, r1 = 0, r2 = 0; float w1 = 0.f, w2 = 0.f; const int token = blk * 128 + F.wave * 16 + (F.lane & 15);
        if (F.lane < 16) {
            const LAS float* L = lg + F.lane * 80;
            float gl[8];
#pragma unroll
            for (int i = 0; i < 8; ++i) gl[i] = L[i] + brl[i];
            int g = 0; float gm = gl[0];
#pragma unroll
            for (int i = 1; i < 8; ++i) if (gl[i] > gm) { gm = gl[i]; g = i; }
            float gs = 0.f;
#pragma unroll
            for (int i = 0; i < 8; ++i) gs += __expf(gl[i] - gm);
            const float gp = 1.0f / gs;
            float el[8];
#pragma unroll
            for (int i = 0; i < 8; ++i) el[i] = L[8 + g * 8 + i] + brl[8 + g * 8 + i];
            int e1 = 0; float m1 = el[0];
#pragma unroll
            for (int i = 1; i < 8; ++i) if (el[i] > m1) { m1 = el[i]; e1 = i; }
            int e2 = -1; float m2 = -3.0e38f;
#pragma unroll
            for (int i = 0; i < 8; ++i) if (i != e1 && el[i] > m2) { m2 = el[i]; e2 = i; }
            if (e2 < 0) e2 = (e1 + 1) & 7;
            const float p = __expf(m2 - m1); w1 = gp / (1.0f + p); w2 = gp * p / (1.0f + p);
            E1 = g * 8 + e1; E2 = g * 8 + e2;
            r1 = atomicAdd((int*)(F.ldsg + LT_HIST) + E1, 1); r2 = atomicAdd((int*)(F.ldsg + LT_HIST) + E2, 1);
        }
        __syncthreads();
        if (F.tid < 64) { const int h = hist[F.tid]; ((LAS int*)(F.lds + LT_BASE))[F.tid] = h ? __hip_atomic_fetch_add((int*)(F.ws + WS_CTL) + CW_GCNT + 64 * F.tid, h, __ATOMIC_RELAXED, __HIP_MEMORY_SCOPE_AGENT) : 0; }
        __syncthreads();
        if (F.lane < 16) { const LAS int* bs = (const LAS int*)(F.lds + LT_BASE); v2u* tab = (v2u*)(F.ws + WS_TAB);
            tab[(size_t)E1 * CAPE + bs[E1] + r1] = (v2u){(unsigned)(token * 2), __builtin_bit_cast(unsigned, w1)};
            tab[(size_t)E2 * CAPE + bs[E2] + r2] = (v2u){(unsigned)(token * 2 + 1), __builtin_bit_cast(unsigned, w2)}; }
        __syncthreads();
    }
}

constexpr int LT_TOT2 = MISC_OFF + 1792;
__device__ __forceinline__ void moe_tables(Frame& F) {
    LAS int* pad_start = (LAS int*)(F.lds + LT_PADSTART); LAS int* tile_e = (LAS int*)(F.lds + LT_TILEE); LAS int* tot = (LAS int*)(F.lds + LT_TOT2);
    if (F.tid < 64) { const int cnt = __hip_atomic_load((int*)(F.ws + WS_CTL) + CW_GCNT + 64 * F.tid, __ATOMIC_RELAXED, __HIP_MEMORY_SCOPE_AGENT); tot[F.tid] = cnt;
        const int nt_ = (cnt + 255) >> 8, sm = ((cnt & 255) != 0 && (cnt & 255) <= 128) ? 1 : 0;
        int incl = nt_, inf = nt_ - sm, ins = sm;
#pragma unroll
        for (int o = 1; o < 64; o <<= 1) { const int v = __shfl_up(incl, o), vf = __shfl_up(inf, o), vs = __shfl_up(ins, o); if (F.tid >= o) { incl += v; inf += vf; ins += vs; } }
        const int nfull = __shfl(inf, 63), st = incl - nt_; pad_start[F.tid] = st << 8;
        for (int k = 0; k < nt_ - sm; ++k) tile_e[inf - (nt_ - sm) + k] = (st + k) | (F.tid << 16);
        if (sm) tile_e[nfull + ins - 1] = (st + nt_ - 1) | (F.tid << 16);
        if (F.tid == 63) { pad_start[64] = incl << 8; pad_start[65] = incl; pad_start[66] = nfull; } }
    __syncthreads();
}
__device__ __forceinline__ v2u moe_row(Frame& F, int i, int t, int vcu, int ntiles) {
    const int L = i * F.G + vcu; if (L >= ntiles * 4) return (v2u){0xffffffffu, 0u};
    const int ti = ((const LAS int*)(F.lds + LT_TILEE))[L >> 2], e = ti >> 16, r = (ti & 0xffff) * 256 - ((const LAS int*)(F.lds + LT_PADSTART))[e] + t;
    if (r >= ((const LAS int*)(F.lds + LT_TOT2))[e]) return (v2u){0xffffffffu, 0u};
    return ((const v2u*)(F.ws + WS_TAB))[(size_t)e * CAPE + r];
}

constexpr int P7R = 4;
__device__ __forceinline__ void p7_final(Frame& F) {
    float* z = F.out; const f32x2* statp = (const f32x2*)(F.ws + WS_STATP); const unsigned char* O = F.ws + WS_O; const float* mod = (const float*)(F.ws + WS_MOD);
    { int t_ = threadIdx.x; asm volatile("" : "+v"(t_)); F.tid = t_; F.lane = t_ & 63; }
    { const int blk = blockIdx.x, b = blk >> 6;
        f32x4 g1[4], b1[4], gt[4];
#pragma unroll
        for (int j = 0; j < 4; ++j) { const int col = 4 * F.lane + 256 * j; g1[j] = *(const f32x4*)(F.ln1_g + col); b1[j] = *(const f32x4*)(F.ln1_b + col); gt[j] = *(const f32x4*)(mod + b * NPROJ + 5 * D + col) + 1.0f; }
        LAS f32x4* l2 = (LAS f32x4*)F.lds;
        __syncthreads();
        l2[F.tid] = F.tid < 256 ? ((const f32x4*)F.ln2_g)[F.tid] : ((const f32x4*)F.ln2_b)[F.tid - 256];
        __syncthreads();
        for (int rr = 0; rr < 16; rr += P7R) { const size_t row0 = (size_t)blk * 128 + F.wave * 16 + rr;
            f32x4 zv[P7R][4]; unsigned oa[P7R][4], oc[P7R][4]; f32x2 p[P7R];
#pragma unroll
            for (int u = 0; u < P7R; ++u) { const size_t row = row0 + u;
                p[u] = (f32x2){0.f, 0.f}; if (F.lane < 16) p[u] = statp[row * 16 + F.lane];
                const GAS f32x4* zr = (const GAS f32x4*)(z + row * D) + F.lane;
                const GAS unsigned* o1 = (const GAS unsigned*)(O + (2 * row) * D) + F.lane; const GAS unsigned* o2 = (const GAS unsigned*)(O + (2 * row + 1) * D) + F.lane;
#pragma unroll
                for (int j = 0; j < 4; ++j) { zv[u][j] = __builtin_nontemporal_load(zr + 64 * j); oa[u][j] = __builtin_nontemporal_load(o1 + 64 * j); oc[u][j] = __builtin_nontemporal_load(o2 + 64 * j); } }
            float s[P7R];
#pragma unroll
            for (int u = 0; u < P7R; ++u) {
                const float mean = wave_sum(p[u].x) * (1.0f / D), rstd = 1.0f / sqrtf(wave_sum(p[u].y) * (1.0f / D) - mean * mean + LN_EPS);
                s[u] = 0.f;
#pragma unroll
                for (int j = 0; j < 4; ++j) { const f32x2 a0 = __builtin_amdgcn_cvt_pk_f32_fp8((int)oa[u][j], false), a1 = __builtin_amdgcn_cvt_pk_f32_fp8((int)oa[u][j], true);
                    const f32x2 c0 = __builtin_amdgcn_cvt_pk_f32_fp8((int)oc[u][j], false), c1 = __builtin_amdgcn_cvt_pk_f32_fp8((int)oc[u][j], true);
                    const f32x4 y = (f32x4){a0[0] + c0[0], a0[1] + c0[1], a1[0] + c1[0], a1[1] + c1[1]} * (1.0f / pg8::O8_SCALE);
                    const f32x4 x1 = (zv[u][j] - mean) * rstd * g1[j] + b1[j];
                    zv[u][j] = x1 * ALPHA + gt[j] * y; s[u] += (zv[u][j][0] + zv[u][j][1]) + (zv[u][j][2] + zv[u][j][3]); } }
#pragma unroll
            for (int u = 0; u < P7R; ++u) { const size_t row = row0 + u;
                const float mean2 = wave_sum(s[u]) * (1.0f / D); float s2 = 0.f;
#pragma unroll
                for (int j = 0; j < 4; ++j) { zv[u][j] = zv[u][j] - mean2; s2 += (zv[u][j][0] * zv[u][j][0] + zv[u][j][1] * zv[u][j][1]) + (zv[u][j][2] * zv[u][j][2] + zv[u][j][3] * zv[u][j][3]); }
                const float rstd2 = 1.0f / sqrtf(wave_sum(s2) * (1.0f / D) + LN_EPS);
                GAS f32x4* zw = (GAS f32x4*)(z + row * D) + F.lane;
#pragma unroll
                for (int j = 0; j < 4; ++j) __builtin_nontemporal_store(zv[u][j] * rstd2 * l2[F.lane + 64 * j] + l2[256 + F.lane + 64 * j], zw + 64 * j); }
        }
    }
}

__device__ __forceinline__ void fill_rs(Frame& F, int t, int vcu, int ntiles) {
    LAS v2u* rs = (LAS v2u*)(F.lds + LT_HIST); v2u en[5];
#pragma unroll
    for (int i = 0; i < 5; ++i) en[i] = moe_row(F, i, t, vcu, ntiles);
#pragma unroll
    for (int i = 0; i < 5; ++i) rs[i * 256 + t] = en[i];
}

struct Args { const float* in[21]; float* out; unsigned char* ws; int ph_lo, ph_hi; };
#ifndef MK_N_LAUNCHES
#define MK_N_LAUNCHES 1
#endif
constexpr int N_PHASES = 11;
static_assert(NBLK == 256, "P7 takes one row block per workgroup of the 256-workgroup grid");
#ifndef KNOB_ALIGN
#define KNOB_ALIGN true
#endif
__global__ void __launch_bounds__(NWAVES * 64, 2) fwd(Args args) {
    extern __shared__ __attribute__((aligned(16))) unsigned char lds[];
    Frame F;
    F.lds = (LAS unsigned char*)lds; F.ldsg = lds;
    F.tid = threadIdx.x; F.lane = F.tid & 63; F.wave = __builtin_amdgcn_readfirstlane(F.tid >> 6); F.G = gridDim.x;
    F.ws = args.ws; F.out = args.out; F.ctl = (gu32*)(args.ws + WS_CTL);
    F.x = args.in[0]; F.c = args.in[1]; F.w_ada = args.in[2]; F.b_ada = args.in[3]; F.w_in = args.in[4]; F.conv_w = args.in[5]; F.w_out_conv = args.in[6]; F.w_pool = args.in[7];
    F.pool_scale = args.in[8]; F.w_o = args.in[9]; F.ln1_g = args.in[10]; F.ln1_b = args.in[11]; F.w_group = args.in[12]; F.b_group = args.in[13]; F.w_router = args.in[14];
    F.b_router = args.in[15]; F.w_gate = args.in[16]; F.w_up = args.in[17]; F.w_down = args.in[18]; F.ln2_g = args.in[19]; F.ln2_b = args.in[20];
    for (int u = F.tid; u < (LDS_BYTES - MISC_OFF) / 4; u += NWAVES * 64) ((LAS unsigned*)(F.lds + MISC_OFF))[u] = 0u;
    __syncthreads();
    XcdBarrier bar; bar.bar = (unsigned*)(F.ctl + CW_BAR); bar.x = 0; bar.st = nullptr;
    if (args.ph_hi - args.ph_lo > 1) bar = xcd_barrier_post((unsigned*)(F.ctl + CW_BAR), (volatile LAS unsigned*)(F.lds + MISC_OFF) + 8);
    const int bx = blockIdx.x, vcu = (F.G % 8 == 0) ? (bx % 8) * (F.G / 8) + bx / 8 : bx;

    const int lo = args.ph_lo, hi = args.ph_hi;
#define IN(k) (lo <= (k) && (k) < hi)
#define SEAM(k) do { if (IN(k) && IN((k) + 1)) xcd_barrier(bar); } while (0)
    if (IN(0)) p0a_mod(F);
    SEAM(0);
    if (IN(1)) { for (int i = F.tid; i < 3 * 1024 / 4; i += 512) ((LAS f32x4*)(F.lds + LT_CONVW))[i] = ((const f32x4*)F.conv_w)[i];
      p0b_prologue(F); }
    SEAM(1);
    if (IN(2)) { pg8::Gemm g{(const bf16*)(F.ws + WS_U), (const bf16*)(F.ws + WS_WIN), M, NPROJ, D}; pg8::StaticOrder S; S.init(M, NPROJ, F.G, bx);
      pg8::EpiProj E{(bf16*)F.out, F.ws + WS_GA, (bf16*)(F.ws + WS_Q), F.ws + WS_GB, (bf16*)(F.ws + WS_RAW), (bf16*)(F.ws + WS_RAW) + 128 * 2 * 1024, (bf16*)(F.ws + WS_RAW) + 2 * 128 * 2 * 1024, (const LAS float*)(F.lds + LT_CONVW), (LAS float*)(F.lds + RING_BYTES)};
      if (!IN(1)) { for (int i = F.tid; i < 3 * 1024 / 4; i += 512) ((LAS f32x4*)(F.lds + LT_CONVW))[i] = ((const f32x4*)F.conv_w)[i]; }
      __syncthreads();
      const int pj = (bx >> 3) & 7, nA = (pj >> 1) * 4;
      pg8::RangeOrder SA{S, 0, nA}, SB{S, nA, 12 - nA};
      pg8::gemm_phase<pg8::EpiProj, pg8::RangeOrder, KNOB_ALIGN, true>(F.lds + RING_OFF, g, SA, E);
      __syncthreads(); convert_experts(F, blockIdx.x, F.G); __syncthreads();
      pg8::gemm_phase<pg8::EpiProj, pg8::RangeOrder, KNOB_ALIGN, true>(F.lds + RING_OFF, g, SB, E); }
    SEAM(2);
    if (IN(4)) { pg8::Gemm g{(const bf16*)F.out, (const bf16*)(F.ws + WS_WOC), M, D, D};
      pg8::StaticOrder S; S.init(M, D, F.G, bx);
      pg8::EpiMerge E{F.ws + WS_GA, F.ws + WS_GB, (const bf16*)(F.ws + WS_Q), (bf16*)(F.ws + WS_MG)};
      { pg8::Unit u0, u1; const bool h0 = S.next(0, u0), h1 = S.next(1, u1); if (h0) conv_fixup2(F, u0.pm, h1 ? u1.pm : u0.pm, h1 ? 2 : 1);
        VM_WAIT(); __syncthreads(); }
      pg8::gemm_phase<pg8::EpiMerge, pg8::StaticOrder, KNOB_ALIGN, true>(F.lds + RING_OFF, g, S, E); }
    SEAM(4);
    if (IN(5)) { pg8::Gemm g{(const bf16*)(F.ws + WS_MG), (const bf16*)(F.ws + WS_WO), M, D, D}; pg8::StaticOrder S; S.init(M, D, F.G, bx);
      pg8::EpiZ E{F.x, F.out, (const float*)(F.ws + WS_MOD), (pg8::f32x2*)(F.ws + WS_STATP), ALPHA};
      pg8::gemm_phase<pg8::EpiZ, pg8::StaticOrder, KNOB_ALIGN, true>(F.lds + RING_OFF, g, S, E); }
    SEAM(5);
    if (IN(6)) p4_route(F);
    SEAM(6);
    if (IN(8)) { moe_tables(F);
      const int ntiles = ((LAS int*)(F.lds + LT_PADSTART))[65];
      pg8::Gemm g{(const bf16*)(F.ws + WS_H), (const bf16*)(F.ws + WS_WGU), CAP, 4 * 256, D / 2};
      pg8::MoeOrder S{F.G, vcu, ntiles * 4, ((LAS int*)(F.lds + LT_PADSTART))[66], (const LAS int*)(F.lds + LT_TILEE)};
      pg8::EpiGU E{F.ws + WS_ACT};
      LAS unsigned short* toks = (LAS unsigned short*)(F.lds + RING_BYTES);
      {
        if (F.tid < 256) { int tk[5];
#pragma unroll
          for (int i = 0; i < 5; ++i) { const v2u en = moe_row(F, i, F.tid, vcu, ntiles); tk[i] = (int)en.x < 0 ? 0 : (int)(en.x >> 1); }
#pragma unroll
          for (int i = 0; i < 5; ++i) toks[i * 256 + F.tid] = (unsigned short)tk[i]; }
        else fill_rs(F, F.tid - 256, vcu, ntiles);
        __syncthreads(); }
      pg8::gemm_phase<pg8::EpiGU, pg8::MoeOrder, KNOB_ALIGN, true, true, pg8::NoPost, true>(F.lds + RING_OFF, g, S, E, toks); }
    SEAM(8);
    if (IN(9)) { if (!IN(8)) moe_tables(F);
      const int ntiles = ((LAS int*)(F.lds + LT_PADSTART))[65];
      pg8::Gemm g{(const bf16*)(F.ws + WS_ACT), (const bf16*)(F.ws + WS_WD), CAP, 4 * 256, DE / 2};
      pg8::MoeOrder S{F.G, vcu, ntiles * 4, ((LAS int*)(F.lds + LT_PADSTART))[66], (const LAS int*)(F.lds + LT_TILEE)};
      LAS v2u* rs = (LAS v2u*)(F.lds + LT_HIST);
      if (!IN(8)) { if (F.tid < 256) fill_rs(F, F.tid, vcu, ntiles); __syncthreads(); }
      pg8::EpiDown E{F.ws + WS_O, (const LAS pg8::u32x2*)rs};
      pg8::gemm_phase<pg8::EpiDown, pg8::MoeOrder, KNOB_ALIGN, true, false, pg8::NoPost, true>(F.lds + RING_OFF, g, S, E); }
    SEAM(9);
    if (IN(10)) p7_final(F);
#undef IN
#undef SEAM
}

extern "C" void kernel_launch(void* const* d_in, const int* in_sizes, int n_in, void* d_out, int out_size, void* d_ws, size_t ws_size, hipStream_t stream) {
    static int grid = 0;
    if (grid == 0) {
        if (n_in != 21 || in_sizes[0] != M * D || out_size != M * D || ws_size < WS_END) { fprintf(stderr, "kernel_launch: built for 21 inputs, x/out of %d floats, >= %zu bytes of workspace; got n_in %d, in0 %d, out %d, ws %zu; nothing launched\n", M * D, (size_t)WS_END, n_in, n_in > 0 ? in_sizes[0] : -1, out_size, ws_size); grid = -1; return; }
        int dev = 0, cus = 0, per_cu = 0;
        if (hipGetDevice(&dev) != hipSuccess || hipDeviceGetAttribute(&cus, hipDeviceAttributeMultiprocessorCount, dev) != hipSuccess) { fprintf(stderr, "kernel_launch: device query failed\n"); grid = -1; return; }
        if (hipFuncSetAttribute((const void*)fwd, hipFuncAttributeMaxDynamicSharedMemorySize, LDS_BYTES) != hipSuccess) { fprintf(stderr, "kernel_launch: hipFuncSetAttribute failed\n"); grid = -1; return; }
        if (hipOccupancyMaxActiveBlocksPerMultiprocessor(&per_cu, (const void*)fwd, NWAVES * 64, LDS_BYTES) != hipSuccess || per_cu < 1) fprintf(stderr, "kernel_launch: note: occupancy query reports %d workgroups per CU\n", per_cu);
        (void)hipGetLastError();
        if (cus < 256) { fprintf(stderr, "kernel_launch: built for 256 CUs (per-workgroup LDS tables hold <= 5 expert units), found %d\n", cus); grid = -1; return; }
        grid = 256;
    }
    if (grid < 0) return;
    if (hipMemsetAsync((char*)d_ws + WS_CTL, 0, CTL_ZERO_BYTES, stream) != hipSuccess) { fprintf(stderr, "kernel_launch: memset failed\n"); return; }
    Args a{};
    for (int i = 0; i < 21; ++i) a.in[i] = (const float*)d_in[i];
    a.out = (float*)d_out; a.ws = (unsigned char*)d_ws;
#if MK_N_LAUNCHES == 1
    a.ph_lo = 0; a.ph_hi = N_PHASES;
    hipLaunchKernelGGL(fwd, dim3(grid), dim3(NWAVES * 64), LDS_BYTES, stream, a);
#else
    for (int p = 0; p < N_PHASES; ++p) {
        a.ph_lo = p; a.ph_hi = p + 1; hipLaunchKernelGGL(fwd, dim3(grid), dim3(NWAVES * 64), LDS_BYTES, stream, a);
    }
#endif
    const hipError_t le = hipPeekAtLastError();
    if (le != hipSuccess) fprintf(stderr, "kernel_launch: launch failed: %s\n", hipGetErrorName(le));
}
```
